# Optimizing an MI355X kernel written in HIP

```python
import math
import jax, jax.numpy as jnp
from jax import lax
import numpy as np

D_MODEL = 1024
BATCH = 8
SEQ = 2048
DEPTH = 4

RET_HEADS = 4
RET_DK = 128
RET_DV = 256
RET_QK = RET_HEADS * RET_DK
RET_V = RET_HEADS * RET_DV
RET_CHUNK = 128
MOBA_HEADS = 8
MOBA_DH = 128
MOBA_W = MOBA_HEADS * MOBA_DH
MOBA_BLOCK = 256
MOBA_TOPK = 3
MOBA_QCHUNK = 16
IN_WIDTHS = (RET_QK, RET_QK, RET_V, RET_V, MOBA_W, MOBA_W, MOBA_W, MOBA_W, D_MODEL, D_MODEL)
D_IN = sum(IN_WIDTHS)
NORM_EPS = 1e-6

kernel_name = "hybrid_retention_moba_gated"


def rmsnorm(x, w):
    xf = x.astype(jnp.float32)
    xf = xf * lax.rsqrt(jnp.mean(xf * xf, axis=-1, keepdims=True) + NORM_EPS)
    return (xf * w.astype(jnp.float32)).astype(x.dtype)


def split_heads(t, n):
    b, s, _ = t.shape
    return t.reshape(b, s, n, -1).transpose(0, 2, 1, 3)


def merge_heads(t):
    b, n, s, d = t.shape
    return t.transpose(0, 2, 1, 3).reshape(b, s, n * d)


def retention(q, k, v):
    b, h, s, dk = q.shape
    dv = v.shape[-1]
    c = RET_CHUNK
    nc = s // c
    q = q.astype(jnp.float32)
    k = k.astype(jnp.float32) * (dk ** -0.5)
    v = v.astype(jnp.float32)
    log_g = jnp.log1p(-jnp.exp2(-5.0 - jnp.arange(h, dtype=jnp.float32)))
    n = jnp.arange(c, dtype=jnp.float32)
    rel = n[:, None] - n[None, :]
    decay_in = jnp.where(rel[None] >= 0, jnp.exp(jnp.maximum(rel, 0.0)[None] * log_g[:, None, None]), 0.0)
    xi = jnp.exp((n + 1.0)[None, :] * log_g[:, None])[None, :, :, None]
    zeta = jnp.exp((c - 1.0 - n)[None, :] * log_g[:, None])[None, :, :, None]
    g_chunk = jnp.exp(c * log_g)[None, :, None, None]

    def to_chunks(t):
        return jnp.moveaxis(t.reshape(b, h, nc, c, t.shape[-1]), 2, 0)

    def step(state, xs):
        qi, ki, vi = xs
        inner = jnp.einsum('bhnd,bhmd->bhnm', qi, ki) * decay_in
        o = jnp.einsum('bhnm,bhmv->bhnv', inner, vi) + jnp.einsum('bhnd,bhdv->bhnv', qi * xi, state)
        state = g_chunk * state + jnp.einsum('bhmd,bhmv->bhdv', ki * zeta, vi)
        return state, o

    state0 = jnp.zeros((b, h, dk, dv), jnp.float32)
    _, o = lax.scan(step, state0, (to_chunks(q), to_chunks(k), to_chunks(v)))
    return jnp.moveaxis(o, 0, 2).reshape(b, h, s, dv)


def head_groupnorm(o, w):
    mu = jnp.mean(o, axis=-1, keepdims=True)
    var = jnp.mean(jnp.square(o - mu), axis=-1, keepdims=True)
    o = (o - mu) * lax.rsqrt(var + NORM_EPS)
    return merge_heads(o) * w.astype(jnp.float32)


def moba_attention(q, k, v):
    b, h, s, dh = q.shape
    bs = MOBA_BLOCK
    nb = -(-s // bs)
    sp = nb * bs
    if sp > s:
        pad = ((0, 0), (0, 0), (0, sp - s), (0, 0))
        q, k, v = jnp.pad(q, pad), jnp.pad(k, pad), jnp.pad(v, pad)
    scale = dh ** -0.5
    topk = min(MOBA_TOPK, nb)
    slopes = jnp.exp2(-8.0 * (jnp.arange(h, dtype=jnp.float32) + 1.0) / h)
    kb = k.reshape(b, h, nb, bs, dh)
    vb = v.reshape(b, h, nb, bs, dh)
    kmean = jnp.mean(kb.astype(jnp.float32), axis=3)
    gate = jnp.einsum('bhtd,bhjd->bhtj', q.astype(jnp.float32), kmean)
    qblk = jnp.arange(sp) // bs
    past = jnp.arange(nb)[None, :] < qblk[:, None]
    gate = jnp.where(past[None, None], gate, -jnp.inf)
    _, idx = lax.top_k(gate, topk)
    valid = jnp.arange(topk)[None, :] < jnp.minimum(qblk, topk)[:, None]

    nq = sp // MOBA_QCHUNK
    qc_all = jnp.moveaxis(q.reshape(b, h, nq, MOBA_QCHUNK, dh), 2, 0)
    ic_all = jnp.moveaxis(idx.reshape(b, h, nq, MOBA_QCHUNK, topk), 2, 0)
    vc_all = valid.reshape(nq, MOBA_QCHUNK, topk)
    bi = jnp.arange(b)[:, None, None, None]
    hi = jnp.arange(h)[None, :, None, None]
    koff = jnp.arange(bs)

    def chunk(xs):
        qc, ic, vc, cid = xs
        tpos = cid * MOBA_QCHUNK + jnp.arange(MOBA_QCHUNK)
        blk = (cid * MOBA_QCHUNK) // bs
        ks = kb[bi, hi, ic]
        vs = vb[bi, hi, ic]
        s_sel = jnp.einsum('bhqd,bhqjkd->bhqjk', qc, ks).astype(jnp.float32) * scale
        dist_sel = (tpos[None, None, :, None, None] - (ic[..., None] * bs + koff)).astype(jnp.float32)
        s_sel = jnp.where(vc[None, None, :, :, None], s_sel - slopes[None, :, None, None, None] * dist_sel, -jnp.inf)
        s_sel = s_sel.reshape(b, h, MOBA_QCHUNK, topk * bs)
        k_own = lax.dynamic_index_in_dim(kb, blk, axis=2, keepdims=False)
        v_own = lax.dynamic_index_in_dim(vb, blk, axis=2, keepdims=False)
        s_own = jnp.einsum('bhqd,bhkd->bhqk', qc, k_own).astype(jnp.float32) * scale
        dist_own = tpos[:, None] - (blk * bs + koff)[None, :]
        s_own = jnp.where(dist_own[None, None] >= 0,
                          s_own - slopes[None, :, None, None] * dist_own.astype(jnp.float32)[None, None], -jnp.inf)
        p = jax.nn.softmax(jnp.concatenate([s_sel, s_own], axis=-1), axis=-1).astype(v.dtype)
        p_sel, p_own = p[..., :topk * bs], p[..., topk * bs:]
        o = jnp.einsum('bhqn,bhqnd->bhqd', p_sel, vs.reshape(b, h, MOBA_QCHUNK, topk * bs, dh))
        return o + jnp.einsum('bhqk,bhkd->bhqd', p_own, v_own)

    o = lax.map(chunk, (qc_all, ic_all, vc_all, jnp.arange(nq)))
    return jnp.moveaxis(o, 0, 2).reshape(b, h, sp, dh)[:, :, :s]


def hybrid_layer(x, ln_w, w_in, ret_gn_w, w_ret_o, w_moba_o, w_out):
    h = rmsnorm(x, ln_w)
    proj = jnp.einsum('bsd,de->bse', h, w_in)
    splits = [int(o) for o in np.cumsum(IN_WIDTHS)[:-1]]
    rq, rk, rv, rg, mq, mk, mv, mg, gr, gm = jnp.split(proj, splits, axis=-1)
    ret = retention(split_heads(rq, RET_HEADS), split_heads(rk, RET_HEADS), split_heads(rv, RET_HEADS))
    ret = head_groupnorm(ret, ret_gn_w).astype(x.dtype) * jax.nn.silu(rg)
    ret = jnp.einsum('bsv,vd->bsd', ret, w_ret_o)
    mo = moba_attention(split_heads(mq, MOBA_HEADS), split_heads(mk, MOBA_HEADS), split_heads(mv, MOBA_HEADS))
    mo = merge_heads(mo) * jax.nn.silu(mg)
    mo = jnp.einsum('bsv,vd->bsd', mo, w_moba_o)
    y = jax.nn.sigmoid(gr) * ret + jax.nn.sigmoid(gm) * mo
    return x + jnp.einsum('bsd,de->bse', y, w_out)


def setup_inputs(seed: int = 0) -> dict:
    key = jax.random.key(seed)
    ks = jax.random.split(key, 9)
    d = D_MODEL
    x = jax.random.normal(ks[0], (BATCH, SEQ, d), jnp.float32)
    ln_w = 1.0 + 0.02 * jax.random.normal(ks[1], (DEPTH, d), jnp.float32)
    w_in = jax.random.normal(ks[2], (DEPTH, d, D_IN), jnp.float32) * d ** -0.5
    ret_gn_w = 1.0 + 0.02 * jax.random.normal(ks[3], (DEPTH, RET_V), jnp.float32)
    w_ret_o = jax.random.normal(ks[4], (DEPTH, RET_V, d), jnp.float32) * RET_V ** -0.5
    w_moba_o = jax.random.normal(ks[5], (DEPTH, MOBA_W, d), jnp.float32) * MOBA_W ** -0.5
    w_out = jax.random.normal(ks[6], (DEPTH, d, d), jnp.float32) * d ** -0.5
    final_norm_w = 1.0 + 0.02 * jax.random.normal(ks[7], (d,), jnp.float32)
    return {"x": x, "ln_w": ln_w, "w_in": w_in, "ret_gn_w": ret_gn_w, "w_ret_o": w_ret_o,
            "w_moba_o": w_moba_o, "w_out": w_out, "final_norm_w": final_norm_w}


def reference(x, ln_w, w_in, ret_gn_w, w_ret_o, w_moba_o, w_out, final_norm_w):
    for layer in range(DEPTH):
        x = hybrid_layer(x, ln_w[layer], w_in[layer], ret_gn_w[layer], w_ret_o[layer],
                         w_moba_o[layer], w_out[layer])
    return rmsnorm(x, final_norm_w)
```

```cpp
#include <hip/hip_runtime.h>
#include <cstdio>
#include <cstdint>

constexpr int DM = 1024, BATCH = 8, SEQ = 2048, DEPTH = 4, M = BATCH * SEQ, D_IN = 9216;
constexpr int CT_RQ = 0, CT_RK = 2, CT_RV = 4, CT_RG = 8, CT_MQ = 12, CT_MK = 16, CT_MV = 20, CT_MG = 24, CT_GR = 28, CT_GM = 32;
constexpr float NORM_EPS = 1e-6f;
constexpr int NWAVES = 8, NTHR = 512;

constexpr size_t MiB = 1u << 20;
constexpr size_t WS_CTL = 0, CTL_ZERO_BYTES = 2 * MiB;
constexpr size_t WS_KMEAN = 1 * MiB;
constexpr size_t WS_WIN = 2 * MiB;
constexpr size_t WS_WRO = 74 * MiB, WS_WMO = 82 * MiB, WS_WOUT = 90 * MiB;
constexpr size_t WS_X = 98 * MiB;
constexpr size_t WS_XN = 162 * MiB;
constexpr size_t WS_PROJ = 194 * MiB;
constexpr size_t WS_RETG = 482 * MiB, WS_MOG = 514 * MiB;
constexpr size_t WS_Y = WS_PROJ;
constexpr size_t WS_YTMP = WS_PROJ + 32 * MiB;
constexpr size_t WS_END = 546 * MiB;
constexpr int CW_BAR = 4096;

typedef unsigned short bf16;
typedef float f32x16 __attribute__((ext_vector_type(16)));
typedef float f32x4 __attribute__((ext_vector_type(4)));
#define LAS __attribute__((address_space(3)))
#define GAS __attribute__((address_space(1)))

__device__ __forceinline__ float bf2f(bf16 u) { return __uint_as_float((unsigned)u << 16); }
__device__ __forceinline__ bf16 f2bf(float f) { unsigned u = __float_as_uint(f); return (bf16)((u + 0x7fffu + ((u >> 16) & 1u)) >> 16); }
__device__ __forceinline__ float sigmoidf_(float x) { return 1.0f / (1.0f + expf(-x)); }
__device__ __forceinline__ float siluf_(float x) { return x / (1.0f + expf(-x)); }
__device__ __forceinline__ float wave_sum(float v) {
#pragma unroll
    for (int o = 1; o < 64; o <<= 1) v += __shfl_xor(v, o);
    return v;
}
__device__ __forceinline__ size_t proj_idx(int ct, int row, int c) { return ((size_t)ct * M + row) * 256 + c; }

#define XB_TMO      128
#define XB_XCNT(j)  (256  + 64 * (j))
#define XB_XSUB(j)  (1280 + 64 * (j))
#define XB_XGEN(j)  (2304 + 64 * (j))
#define XB_TOP      3328
#define XB_TOPGEN   3392
#define XCD_BAR_WORDS 3456
#define XB_SPIN_CAP (1u << 25)
__device__ __forceinline__ unsigned xb_ld(unsigned* p)              { return __hip_atomic_load(p, __ATOMIC_RELAXED, __HIP_MEMORY_SCOPE_AGENT); }
__device__ __forceinline__ unsigned xb_add(unsigned* p, unsigned v) { return __hip_atomic_fetch_add(p, v, __ATOMIC_RELAXED, __HIP_MEMORY_SCOPE_AGENT); }
__device__ __forceinline__ unsigned xb_xcc_id() { return (unsigned)__builtin_amdgcn_s_getreg((3 << 11) | 20) & 0xFu; }
#define XB_SPIN(cond, bar) do { unsigned _sp = 0; while (cond) { __builtin_amdgcn_s_sleep(1); \
    if ((++_sp & 255u) == 0u) { if (xb_ld(&(bar)[XB_TMO])) break; if (_sp > XB_SPIN_CAP) { atomicAdd(&(bar)[XB_TMO], 1u); break; } } } } while (0)
struct XcdBarrier { unsigned* bar; unsigned x; volatile LAS unsigned* st; };
__device__ __forceinline__ XcdBarrier xcd_barrier_post(unsigned* bar, volatile LAS unsigned* st) {
    XcdBarrier b; b.bar = bar; b.x = xb_xcc_id(); b.st = st;
    if (threadIdx.x == 0) (void)xb_add(&bar[XB_XCNT(b.x)], 1u);
    return b;
}
__device__ __forceinline__ void xcd_barrier_complete(unsigned* bar, unsigned x, unsigned& nloc, unsigned& nx) {
    const unsigned G = gridDim.x * gridDim.y * gridDim.z;
    unsigned sum, cnt, mine, sp = 0u;
    for (;;) {
        sum = 0u; cnt = 0u; mine = 0u;
#pragma unroll
        for (unsigned j = 0; j < 16; ++j) { const unsigned c = xb_ld(&bar[XB_XCNT(j)]); sum += c; cnt += (c > 0u) ? 1u : 0u; mine = (j == x) ? c : mine; }
        if (sum == G) break;
        __builtin_amdgcn_s_sleep(1);
        if ((++sp & 255u) == 0u) { if (xb_ld(&bar[XB_TMO])) break; if (sp > XB_SPIN_CAP) { atomicAdd(&bar[XB_TMO], 1u); break; } }
    }
    nloc = mine > 0u ? mine : 1u; nx = cnt > 0u ? cnt : 1u;
}
__device__ __forceinline__ void xcd_barrier(const XcdBarrier& b) {
    asm volatile("s_waitcnt vmcnt(0)" ::: "memory");
    __syncthreads();
    if (threadIdx.x == 0) {
        unsigned* bar = b.bar;
        __builtin_amdgcn_s_waitcnt(0);
        unsigned nloc = b.st[0], nx = b.st[1];
        if (nloc == 0u) { xcd_barrier_complete(bar, b.x, nloc, nx); b.st[0] = nloc; b.st[1] = nx; }
        const unsigned old = xb_add(&bar[XB_XSUB(b.x)], 1u);
        const unsigned gen = old / nloc;
        if (old + 1u == (gen + 1u) * nloc) {
            __builtin_amdgcn_fence(__ATOMIC_RELEASE, "agent");
            asm volatile("s_waitcnt vmcnt(0)" ::: "memory");
            const unsigned og = xb_add(&bar[XB_TOP], 1u);
            const unsigned tg = og / nx;
            if (og + 1u == (tg + 1u) * nx) xb_add(&bar[XB_TOPGEN], 1u);
            else XB_SPIN(xb_ld(&bar[XB_TOPGEN]) == tg, bar);
            __builtin_amdgcn_fence(__ATOMIC_ACQUIRE, "agent");
            xb_add(&bar[XB_XGEN(b.x)], 1u);
            asm volatile("s_waitcnt vmcnt(0)" ::: "memory");
        } else {
            XB_SPIN(xb_ld(&bar[XB_XGEN(b.x)]) == gen, bar);
            __builtin_amdgcn_fence(__ATOMIC_ACQUIRE, "agent");
            asm volatile("s_waitcnt vmcnt(0)" ::: "memory");
        }
    }
    __syncthreads();
}

__device__ __forceinline__ void ph_rmsnorm(const float* X, const float* w, bf16* XN, float* OUT) {
    const int lane = threadIdx.x & 63, wave = threadIdx.x >> 6;
    for (int row = blockIdx.x * NWAVES + wave; row < M; row += gridDim.x * NWAVES) {
        const f32x4* xr = (const f32x4*)(X + (size_t)row * DM) + lane;
        f32x4 v[4]; float ss = 0.f;
#pragma unroll
        for (int j = 0; j < 4; ++j) { v[j] = xr[64 * j]; ss += v[j].x * v[j].x + v[j].y * v[j].y + v[j].z * v[j].z + v[j].w * v[j].w; }
        ss = wave_sum(ss);
        const float rstd = 1.0f / sqrtf(ss * (1.0f / DM) + NORM_EPS);
#pragma unroll
        for (int j = 0; j < 4; ++j) {
            const int col = (lane + 64 * j) * 4; const f32x4 w4 = *(const f32x4*)(w + col);
            const f32x4 o = v[j] * rstd * w4;
            if (XN) { uint2 pk; pk.x = (unsigned)f2bf(o.x) | ((unsigned)f2bf(o.y) << 16); pk.y = (unsigned)f2bf(o.z) | ((unsigned)f2bf(o.w) << 16); *(uint2*)(XN + (size_t)row * DM + col) = pk; }
            if (OUT) *(f32x4*)(OUT + (size_t)row * DM + col) = o;
        }
    }
}

template <class EP>
__device__ __forceinline__ void ngemm(const bf16* A, int lda, const float* W, int N, int K, EP ep) {
    const int lane = threadIdx.x & 63, wave = threadIdx.x >> 6, r32 = lane & 31, h = lane >> 5;
    const int ntn = N / 32, ntm = M / 32, NWG = gridDim.x * NWAVES;
    for (int t = blockIdx.x * NWAVES + wave; t < ntm * ntn; t += NWG) {
        const int mt = t / ntn, nt = t % ntn;
        f32x16 acc = {};
        const bf16* ap = A + (size_t)(mt * 32 + r32) * lda + 4 * h;
        const float* wp = W + (size_t)(4 * h) * N + nt * 32 + r32;
        for (int k0 = 0; k0 < K; k0 += 8) {
            const uint2 a2 = *(const uint2*)(ap + k0);
            const float a0 = __uint_as_float(a2.x << 16), a1 = __uint_as_float(a2.x & 0xffff0000u), a2f = __uint_as_float(a2.y << 16), a3 = __uint_as_float(a2.y & 0xffff0000u);
            const float b0 = wp[(size_t)(k0 + 0) * N], b1 = wp[(size_t)(k0 + 1) * N], b2 = wp[(size_t)(k0 + 2) * N], b3 = wp[(size_t)(k0 + 3) * N];
            acc = __builtin_amdgcn_mfma_f32_32x32x2f32(a0, b0, acc, 0, 0, 0);
            acc = __builtin_amdgcn_mfma_f32_32x32x2f32(a1, b1, acc, 0, 0, 0);
            acc = __builtin_amdgcn_mfma_f32_32x32x2f32(a2f, b2, acc, 0, 0, 0);
            acc = __builtin_amdgcn_mfma_f32_32x32x2f32(a3, b3, acc, 0, 0, 0);
        }
#pragma unroll
        for (int r = 0; r < 16; ++r) ep(mt * 32 + (r & 3) + 8 * (r >> 2) + 4 * h, nt * 32 + r32, acc[r]);
    }
}

__device__ __forceinline__ void ph_kmean(const bf16* PROJ, float* kmean) {
    for (int o = blockIdx.x * NTHR + threadIdx.x; o < BATCH * 8 * 8 * 128; o += gridDim.x * NTHR) {
        const int d = o & 127, j = (o >> 7) & 7, h = (o >> 10) & 7, b = o >> 13;
        const bf16* p = PROJ + proj_idx(CT_MK + (h >> 1), b * SEQ + j * 256, (h & 1) * 128 + d);
        float s = 0.f;
        for (int k = 0; k < 256; ++k) s += bf2f(p[(size_t)k * 256]);
        kmean[o] = s * (1.0f / 256.0f);
    }
}

__device__ __forceinline__ void ph_moba_naive(const bf16* PROJ, const float* kmean, bf16* MOG, float* lds) {
    float* qs = lds;
    float* ks = qs + 32 * 132;
    float* vs = ks + 64 * 132;
    float* ss = vs + 64 * 128;
    const int tid = threadIdx.x, q = tid >> 4, part = tid & 15;
    const float scale = 0.08838834764831845f;
    for (int item = blockIdx.x; item < 64 * 64; item += gridDim.x) {
        const int bh = item >> 6, qt = item & 63, b = bh >> 3, h = bh & 7, qb = qt >> 3, t0 = qt * 32;
        const bf16* Qp = PROJ + proj_idx(CT_MQ + (h >> 1), b * SEQ, (h & 1) * 128);
        const bf16* Kp = PROJ + proj_idx(CT_MK + (h >> 1), b * SEQ, (h & 1) * 128);
        const bf16* Vp = PROJ + proj_idx(CT_MV + (h >> 1), b * SEQ, (h & 1) * 128);
        const bf16* Gp = PROJ + proj_idx(CT_MG + (h >> 1), b * SEQ, (h & 1) * 128);
        for (int i = tid; i < 32 * 128; i += NTHR) { const int r = i >> 7, d = i & 127; qs[r * 132 + d] = bf2f(Qp[(size_t)(t0 + r) * 256 + d]); }
        __syncthreads();
        float g[8];
#pragma unroll
        for (int j = 0; j < 8; ++j) {
            float s = 0.f;
            if (j < qb) { const float* km = kmean + ((size_t)(b * 8 + h) * 8 + j) * 128 + part * 8;
#pragma unroll
                for (int d = 0; d < 8; ++d) s += qs[q * 132 + part * 8 + d] * km[d]; }
            s += __shfl_xor(s, 1); s += __shfl_xor(s, 2); s += __shfl_xor(s, 4); s += __shfl_xor(s, 8);
            g[j] = s;
        }
        unsigned sel = 0u;
#pragma unroll
        for (int j = 0; j < 8; ++j) { if (j < qb) { int rank = 0;
#pragma unroll
                for (int j2 = 0; j2 < 8; ++j2) if (j2 < qb && (g[j2] > g[j] || (g[j2] == g[j] && j2 < j))) ++rank;
                if (rank < 3) sel |= 1u << j; } }
        float m = -1e30f, l = 0.f, O[8];
#pragma unroll
        for (int d = 0; d < 8; ++d) O[d] = 0.f;
        const float slope = exp2f(-(float)(h + 1));
        const int t = t0 + q;
        for (int kt = 0; kt < 4 * (qb + 1); ++kt) {
            const int kb = kt * 64, jb = kt >> 2;
            for (int i = tid; i < 64 * 128; i += NTHR) { const int r = i >> 7, d = i & 127; ks[r * 132 + d] = bf2f(Kp[(size_t)(kb + r) * 256 + d]); vs[r * 128 + d] = bf2f(Vp[(size_t)(kb + r) * 256 + d]); }
            __syncthreads();
#pragma unroll
            for (int i = 0; i < 4; ++i) {
                const int key = part * 4 + i; float s = 0.f;
                for (int d = 0; d < 128; ++d) s += qs[q * 132 + d] * ks[key * 132 + d];
                const int dist = t - (kb + key);
                const bool allowed = (jb == qb) ? (dist >= 0) : (((sel >> jb) & 1u) != 0u);
                ss[q * 64 + key] = allowed ? (s * scale - slope * (float)dist) : -__builtin_inff();
            }
            __syncthreads();
            float rm = -__builtin_inff();
            for (int k = 0; k < 64; ++k) rm = fmaxf(rm, ss[q * 64 + k]);
            const float mn = fmaxf(m, rm), alpha = expf(m - mn);
            float ps = 0.f;
#pragma unroll
            for (int d = 0; d < 8; ++d) O[d] *= alpha;
            for (int k = 0; k < 64; ++k) { const float p = expf(ss[q * 64 + k] - mn); ps += p;
#pragma unroll
                for (int d = 0; d < 8; ++d) O[d] += p * vs[k * 128 + part * 8 + d]; }
            l = l * alpha + ps; m = mn;
            __syncthreads();
        }
        const float inv = 1.0f / l;
#pragma unroll
        for (int d = 0; d < 8; ++d) {
            const float gt = bf2f(Gp[(size_t)t * 256 + part * 8 + d]);
            MOG[(size_t)(b * SEQ + t) * DM + h * 128 + part * 8 + d] = f2bf(O[d] * inv * gt);
        }
        __syncthreads();
    }
}

__device__ __forceinline__ void ph_ret_naive(const bf16* PROJ, const float* gn_w, bf16* RETG, float* lds) {
    constexpr int CH = 8;
    float* qs = lds;
    float* ks = qs + CH * 128;
    float* vs = ks + CH * 128;
    float* ot = vs + CH * 256;
    const int tid = threadIdx.x, col = tid & 255, half = tid >> 8, lane = tid & 63, wave = tid >> 6;
    for (int bh = blockIdx.x; bh < BATCH * 4; bh += gridDim.x) {
        const int b = bh >> 2, h = bh & 3;
        const float gamma = 1.0f - exp2f(-5.0f - (float)h);
        const bf16* Qp = PROJ + proj_idx(CT_RQ + (h >> 1), b * SEQ, (h & 1) * 128);
        const bf16* Kp = PROJ + proj_idx(CT_RK + (h >> 1), b * SEQ, (h & 1) * 128);
        const bf16* Vp = PROJ + proj_idx(CT_RV + h, b * SEQ, 0);
        const bf16* Gp = PROJ + proj_idx(CT_RG + h, b * SEQ, 0);
        float S[64];
#pragma unroll
        for (int i = 0; i < 64; ++i) S[i] = 0.f;
        for (int c0 = 0; c0 < SEQ; c0 += CH) {
            for (int i = tid; i < CH * 128; i += NTHR) { const int r = i >> 7, d = i & 127; qs[i] = bf2f(Qp[(size_t)(c0 + r) * 256 + d]); ks[i] = bf2f(Kp[(size_t)(c0 + r) * 256 + d]); }
            for (int i = tid; i < CH * 256; i += NTHR) { const int r = i >> 8, c = i & 255; vs[i] = bf2f(Vp[(size_t)(c0 + r) * 256 + c]); }
            __syncthreads();
#pragma unroll 1
            for (int n = 0; n < CH; ++n) {
                float acc = 0.f; const float vn = vs[n * 256 + col];
                const float* kr = ks + n * 128 + half * 64; const float* qr = qs + n * 128 + half * 64;
#pragma unroll
                for (int d = 0; d < 64; ++d) { S[d] = gamma * S[d] + kr[d] * vn; acc += qr[d] * S[d]; }
                ot[(half * CH + n) * 256 + col] = acc;
            }
            __syncthreads();
            {
                const int n = wave; f32x4 x = *(const f32x4*)&ot[n * 256 + lane * 4]; x += *(const f32x4*)&ot[(CH + n) * 256 + lane * 4];
                const float mu = wave_sum(x.x + x.y + x.z + x.w) * (1.0f / 256.0f);
                const f32x4 dx = x - mu;
                const float var = wave_sum(dx.x * dx.x + dx.y * dx.y + dx.z * dx.z + dx.w * dx.w) * (1.0f / 256.0f);
                const float rs = 1.0f / sqrtf(var + NORM_EPS);
                const int row = b * SEQ + c0 + n;
#pragma unroll
                for (int e = 0; e < 4; ++e) { const int c = lane * 4 + e;
                    const float gt = bf2f(Gp[(size_t)(c0 + n) * 256 + c]);
                    RETG[(size_t)row * DM + h * 256 + c] = f2bf(dx[e] * rs * gn_w[h * 256 + c] * gt); }
            }
            __syncthreads();
        }
    }
}

constexpr int LDS_BYTES = 147456, LDSCTL_OFF = 131072;
struct Args { const float* x; const float* ln_w; const float* w_in; const float* gn_w; const float* w_ro; const float* w_mo; const float* w_out; const float* fn_w;
              float* out; unsigned char* ws; int st_lo, st_hi; };
constexpr int STEPS_PER_LAYER = 6, NSTEPS = DEPTH * STEPS_PER_LAYER + 1;

__global__ void __launch_bounds__(NTHR, 2) hybrid_fwd(Args a) {
    extern __shared__ __attribute__((aligned(16))) unsigned char lds[];
    const int tid = threadIdx.x;
    volatile LAS unsigned* MISC = (volatile LAS unsigned*)((LAS unsigned char*)lds + LDSCTL_OFF);
    for (int u = tid; u < (LDS_BYTES - LDSCTL_OFF) / 4; u += NTHR) MISC[u] = 0u;
    __syncthreads();
    unsigned char* ws = a.ws;
    unsigned* ctl = (unsigned*)(ws + WS_CTL);
    XcdBarrier bar = xcd_barrier_post(ctl + CW_BAR, MISC + 8);
    float* X = (float*)(ws + WS_X); bf16* XN = (bf16*)(ws + WS_XN); bf16* PROJ = (bf16*)(ws + WS_PROJ);
    bf16* RETG = (bf16*)(ws + WS_RETG); bf16* MOG = (bf16*)(ws + WS_MOG); bf16* Y = (bf16*)(ws + WS_Y); float* YTMP = (float*)(ws + WS_YTMP);
    float* ldsf = (float*)lds;

    for (int st = a.st_lo; st < a.st_hi; ++st) {
        if (st == NSTEPS - 1) { ph_rmsnorm(X, a.fn_w, nullptr, a.out); break; }
        const int layer = st / STEPS_PER_LAYER, p = st % STEPS_PER_LAYER;
        const float* Xin = (layer == 0) ? a.x : X;
        float* kmean = (float*)(ws + WS_KMEAN) + (size_t)layer * (BATCH * 8 * 8 * 128);
        if (p == 0) {
            ph_rmsnorm(Xin, a.ln_w + layer * DM, XN, nullptr);
        } else if (p == 1) {
            const float* W = a.w_in + (size_t)layer * DM * D_IN;
            ngemm(XN, DM, W, D_IN, DM, [=](int row, int c, float v) {
                const int ct = c >> 8;
                if (ct >= CT_RK && ct < CT_RV) v *= 0.08838834764831845f;
                else if ((ct >= CT_RG && ct < CT_MQ) || (ct >= CT_MG && ct < CT_GR)) v = siluf_(v);
                else if (ct >= CT_GR) v = sigmoidf_(v);
                PROJ[proj_idx(ct, row, c & 255)] = f2bf(v); });
        } else if (p == 2) {
            ph_kmean(PROJ, kmean);
        } else if (p == 3) {
            ph_ret_naive(PROJ, a.gn_w + layer * DM, RETG, ldsf);
            __syncthreads();
            ph_moba_naive(PROJ, kmean, MOG, ldsf);
        } else if (p == 4) {
            ngemm(RETG, DM, a.w_ro + (size_t)layer * DM * DM, DM, DM, [=](int row, int c, float v) {
                YTMP[(size_t)row * DM + c] = bf2f(PROJ[proj_idx(CT_GR + (c >> 8), row, c & 255)]) * v; });
            ngemm(MOG, DM, a.w_mo + (size_t)layer * DM * DM, DM, DM, [=](int row, int c, float v) {
                const float y = YTMP[(size_t)row * DM + c] + bf2f(PROJ[proj_idx(CT_GM + (c >> 8), row, c & 255)]) * v;
                Y[(size_t)row * DM + c] = f2bf(y); });
        } else {
            ngemm(Y, DM, a.w_out + (size_t)layer * DM * DM, DM, DM, [=](int row, int c, float v) {
                X[(size_t)row * DM + c] = Xin[(size_t)row * DM + c] + v; });
        }
        if (st + 1 < a.st_hi) xcd_barrier(bar);
    }
}

extern "C" void kernel_launch(void* const* d_in, const int* in_sizes, int n_in, void* d_out, int out_size, void* d_ws, size_t ws_size, hipStream_t stream) {
    static int grid = 0;
    if (grid == 0) {
        if (n_in != 8 || in_sizes[0] != M * DM || out_size != M * DM || ws_size < WS_END) {
            fprintf(stderr, "kernel_launch: unexpected shapes / workspace (n_in %d, in0 %d, out %d, ws %zu, need %zu)\n", n_in, n_in > 0 ? in_sizes[0] : -1, out_size, ws_size, (size_t)WS_END);
            grid = -1; return; }
        int dev = 0, cus = 0;
        if (hipGetDevice(&dev) != hipSuccess || hipDeviceGetAttribute(&cus, hipDeviceAttributeMultiprocessorCount, dev) != hipSuccess || cus <= 0) { grid = -1; return; }
        if (hipFuncSetAttribute((const void*)hybrid_fwd, hipFuncAttributeMaxDynamicSharedMemorySize, LDS_BYTES) != hipSuccess) { fprintf(stderr, "kernel_launch: hipFuncSetAttribute failed\n"); grid = -1; return; }
        int per_cu = 0;
        if (hipOccupancyMaxActiveBlocksPerMultiprocessor(&per_cu, (const void*)hybrid_fwd, NTHR, LDS_BYTES) != hipSuccess || per_cu < 1) fprintf(stderr, "kernel_launch: occupancy query says %d\n", per_cu);
        (void)hipGetLastError();
        grid = cus;
    }
    if (grid < 0) return;
    (void)hipMemsetAsync((char*)d_ws + WS_CTL, 0, CTL_ZERO_BYTES, stream);
    Args a{};
    a.x = (const float*)d_in[0]; a.ln_w = (const float*)d_in[1]; a.w_in = (const float*)d_in[2]; a.gn_w = (const float*)d_in[3];
    a.w_ro = (const float*)d_in[4]; a.w_mo = (const float*)d_in[5]; a.w_out = (const float*)d_in[6]; a.fn_w = (const float*)d_in[7];
    a.out = (float*)d_out; a.ws = (unsigned char*)d_ws; a.st_lo = 0; a.st_hi = NSTEPS;
    hipLaunchKernelGGL(hybrid_fwd, dim3(grid), dim3(NTHR), LDS_BYTES, stream, a);
}
```

```cpp
#include <hip/hip_runtime.h>
#include <cstdio>
#include <cstdint>

constexpr int DM = 1024, BATCH = 8, SEQ = 2048, DEPTH = 4, M = BATCH * SEQ, D_IN = 9216;
constexpr int CT_RQ = 0, CT_RK = 2, CT_RV = 4, CT_RG = 8, CT_MQ = 12, CT_MK = 16, CT_MV = 20, CT_MG = 24, CT_GR = 28, CT_GM = 32;
constexpr float NORM_EPS = 1e-6f;
constexpr int NWAVES = 8, NTHR = 512;

constexpr size_t MiB = 1u << 20;
constexpr size_t WS_CTL = 0, CTL_ZERO_BYTES = 2 * MiB;
constexpr size_t WS_KMEAN = 1 * MiB;
constexpr size_t WS_WIN = 2 * MiB;
constexpr size_t WS_WRO = 74 * MiB, WS_WMO = 82 * MiB, WS_WOUT = 90 * MiB;
constexpr size_t WS_X = 98 * MiB;
constexpr size_t WS_XN = 162 * MiB;
constexpr size_t WS_PROJ = 194 * MiB;
constexpr size_t WS_RETG = 482 * MiB, WS_MOG = 514 * MiB;
constexpr size_t WS_Y = WS_PROJ;
constexpr size_t WS_YTMP = WS_PROJ + 32 * MiB;
constexpr size_t WS_END = 546 * MiB;
constexpr int CW_BAR = 4096;

typedef unsigned short bf16;
typedef float f32x16 __attribute__((ext_vector_type(16)));
typedef float f32x4 __attribute__((ext_vector_type(4)));
#define LAS __attribute__((address_space(3)))
#define GAS __attribute__((address_space(1)))

__device__ __forceinline__ int otid() { int t = threadIdx.x; asm volatile("" : "+v"(t)); return t; }
__device__ __forceinline__ float bf2f(bf16 u) { return __uint_as_float((unsigned)u << 16); }
__device__ __forceinline__ bf16 f2bf(float f) { unsigned u = __float_as_uint(f); return (bf16)((u + 0x7fffu + ((u >> 16) & 1u)) >> 16); }
__device__ __forceinline__ float sigmoidf_(float x) { return 1.0f / (1.0f + expf(-x)); }
__device__ __forceinline__ float siluf_(float x) { return x / (1.0f + expf(-x)); }
__device__ __forceinline__ float wave_sum(float v) {
#pragma unroll
    for (int o = 1; o < 64; o <<= 1) v += __shfl_xor(v, o);
    return v;
}
__device__ __forceinline__ size_t proj_idx(int ct, int row, int c) { return ((size_t)ct * M + row) * 256 + c; }

#define XB_TMO      128
#define XB_XCNT(j)  (256  + 64 * (j))
#define XB_XSUB(j)  (1280 + 64 * (j))
#define XB_XGEN(j)  (2304 + 64 * (j))
#define XB_TOP      3328
#define XB_TOPGEN   3392
#define XCD_BAR_WORDS 3456
#define XB_SPIN_CAP (1u << 25)
__device__ __forceinline__ unsigned xb_ld(unsigned* p)              { return __hip_atomic_load(p, __ATOMIC_RELAXED, __HIP_MEMORY_SCOPE_AGENT); }
__device__ __forceinline__ unsigned xb_add(unsigned* p, unsigned v) { return __hip_atomic_fetch_add(p, v, __ATOMIC_RELAXED, __HIP_MEMORY_SCOPE_AGENT); }
__device__ __forceinline__ unsigned xb_xcc_id() { return (unsigned)__builtin_amdgcn_s_getreg((3 << 11) | 20) & 0xFu; }
#define XB_SPIN(cond, bar) do { unsigned _sp = 0; while (cond) { __builtin_amdgcn_s_sleep(1); \
    if ((++_sp & 255u) == 0u) { if (xb_ld(&(bar)[XB_TMO])) break; if (_sp > XB_SPIN_CAP) { atomicAdd(&(bar)[XB_TMO], 1u); break; } } } } while (0)
struct XcdBarrier { unsigned* bar; unsigned x; volatile LAS unsigned* st; };
__device__ __forceinline__ XcdBarrier xcd_barrier_post(unsigned* bar, volatile LAS unsigned* st) {
    XcdBarrier b; b.bar = bar; b.x = xb_xcc_id(); b.st = st;
    if (threadIdx.x == 0) (void)xb_add(&bar[XB_XCNT(b.x)], 1u);
    return b;
}
__device__ __forceinline__ void xcd_barrier_complete(unsigned* bar, unsigned x, unsigned& nloc, unsigned& nx) {
    const unsigned G = gridDim.x * gridDim.y * gridDim.z;
    unsigned sum, cnt, mine, sp = 0u;
    for (;;) {
        sum = 0u; cnt = 0u; mine = 0u;
#pragma unroll
        for (unsigned j = 0; j < 16; ++j) { const unsigned c = xb_ld(&bar[XB_XCNT(j)]); sum += c; cnt += (c > 0u) ? 1u : 0u; mine = (j == x) ? c : mine; }
        if (sum == G) break;
        __builtin_amdgcn_s_sleep(1);
        if ((++sp & 255u) == 0u) { if (xb_ld(&bar[XB_TMO])) break; if (sp > XB_SPIN_CAP) { atomicAdd(&bar[XB_TMO], 1u); break; } }
    }
    nloc = mine > 0u ? mine : 1u; nx = cnt > 0u ? cnt : 1u;
}
__device__ __forceinline__ void xcd_barrier(const XcdBarrier& b) {
    asm volatile("s_waitcnt vmcnt(0)" ::: "memory");
    __syncthreads();
    if (threadIdx.x == 0) {
        unsigned* bar = b.bar;
        __builtin_amdgcn_s_waitcnt(0);
        unsigned nloc = b.st[0], nx = b.st[1];
        if (nloc == 0u) { xcd_barrier_complete(bar, b.x, nloc, nx); b.st[0] = nloc; b.st[1] = nx; }
        const unsigned old = xb_add(&bar[XB_XSUB(b.x)], 1u);
        const unsigned gen = old / nloc;
        if (old + 1u == (gen + 1u) * nloc) {
            __builtin_amdgcn_fence(__ATOMIC_RELEASE, "agent");
            asm volatile("s_waitcnt vmcnt(0)" ::: "memory");
            const unsigned og = xb_add(&bar[XB_TOP], 1u);
            const unsigned tg = og / nx;
            if (og + 1u == (tg + 1u) * nx) xb_add(&bar[XB_TOPGEN], 1u);
            else XB_SPIN(xb_ld(&bar[XB_TOPGEN]) == tg, bar);
            __builtin_amdgcn_fence(__ATOMIC_ACQUIRE, "agent");
            xb_add(&bar[XB_XGEN(b.x)], 1u);
            asm volatile("s_waitcnt vmcnt(0)" ::: "memory");
        } else {
            XB_SPIN(xb_ld(&bar[XB_XGEN(b.x)]) == gen, bar);
            __builtin_amdgcn_fence(__ATOMIC_ACQUIRE, "agent");
            asm volatile("s_waitcnt vmcnt(0)" ::: "memory");
        }
    }
    __syncthreads();
}


namespace pg8 {
#define PG8_LAS __attribute__((address_space(3)))
typedef unsigned short bf16_t;
typedef short bf16x8 __attribute__((ext_vector_type(8)));
typedef float f32x4 __attribute__((ext_vector_type(4)));
typedef unsigned u32x4 __attribute__((ext_vector_type(4)));
constexpr int BM = 256, BK = 64, HALF = 128, HTB = HALF * BK * 2, STAGE_BYTES = 8 * HTB, NXCD = 8, WGM = 8;
__host__ __device__ __forceinline__ int lds_byte(int r, int c) { const int st = (r >> 4) * 2 + (c >> 5), rr = r & 15, cc = c & 31, ob = rr * 64 + cc * 2; return st * 1024 + (ob ^ (((ob >> 9) & 1) << 5)); }
__host__ __device__ __forceinline__ void stage_rc(int b, int& R, int& C) { const int st = b / 1024, sb = b % 1024, swz = sb ^ (((sb >> 9) & 1) << 5); R = (st >> 1) * 16 + swz / 64; C = (st & 1) * 32 + (swz % 64) / 2; }
__host__ __device__ __forceinline__ int perm32(int rho) { const int n = rho >> 4, i = rho & 15; return 8 * (i >> 2) + 4 * n + (i & 3); }
struct Unit { int pm, pn; };
struct Gemm { const bf16_t* A; const bf16_t* Bt; int M, N, K; };
struct StaticOrder {
    int nM, nN, nwg, G, c;
    __host__ __device__ void init(int M, int N, int G_, int c_) { nM = M / BM; nN = N / BM; nwg = nM * nN; G = G_; c = c_; }
    __host__ __device__ bool next(int i, Unit& u) const {
        const long L = (long)i * G + c; if (L >= nwg) return false;
        int wgid = (int)L; { const int q = nwg / NXCD, r = nwg % NXCD, xcd = wgid % NXCD, off = wgid / NXCD; wgid = (xcd < r ? xcd * (q + 1) : r * (q + 1) + (xcd - r) * q) + off; }
        const int nig = WGM * nN, gid = wgid / nig, fm = gid * WGM, gsz = (nM - fm) < WGM ? (nM - fm) : WGM;
        u.pm = fm + ((wgid % nig) % gsz); u.pn = (wgid % nig) / gsz; return true;
    }
    __device__ __forceinline__ void a_ready(const Unit&) const {}
    __device__ __forceinline__ void done(const Unit&) const {}
};
__device__ __forceinline__ unsigned cvt_pk_bf16(float lo, float hi) { unsigned r; asm volatile("v_cvt_pk_bf16_f32 %0, %1, %2" : "=v"(r) : "v"(lo), "v"(hi)); return r; }

template <class Epi, class Sched, bool ALIGN_EPI = false, bool SP2 = false>
__device__ __forceinline__ void gemm_phase(PG8_LAS unsigned char* lds, const Gemm g, const Sched& S, const Epi& E) {
    const int tid = otid(), wid = __builtin_amdgcn_readfirstlane(tid >> 6), lane = tid & 63, wr = wid >> 2, wc = wid & 3, fr = lane & 15, fq = lane >> 4;
    const int K = g.K, nt = K / BK;
    unsigned voffA[2], voffB[2];
#pragma unroll
    for (int i = 0; i < 2; ++i) { int R, C; stage_rc(tid * 16 + i * 8192, R, C); const int Rb = Epi::PERM ? ((R & ~31) + perm32(R & 31)) : R;
        voffA[i] = (unsigned)(R * K + C) * 2u; voffB[i] = (unsigned)(Rb * K + C) * 2u; }
    const size_t kstep = (size_t)(BK * 2);
    const size_t hstep = (size_t)HALF * K * 2;
    const size_t tstep = 2 * hstep;
    const unsigned ldsw = (unsigned)wid * 1024u;
    const int aoff = lds_byte(wr * 64 + fr, fq * 8), boff = lds_byte(wc * 32 + fr, fq * 8);
#define PG8_SA(b, h) (((b) * 2 + (h)) * HTB)
#define PG8_SB(b, h) ((4 + (b) * 2 + (h)) * HTB)
#define PG8_STAGE(bufoff, gbase, voff) do { _Pragma("unroll") for (int _i = 0; _i < 2; ++_i) \
        __builtin_amdgcn_global_load_lds((const unsigned*)((const char*)(gbase) + (voff)[_i]), (PG8_LAS unsigned*)(lds + (bufoff) + ldsw + _i * 8192), 16, 0, 0); } while (0)
#define PG8_LDA(dst, b, h) do { _Pragma("unroll") for (int m = 0; m < 4; ++m) _Pragma("unroll") for (int k = 0; k < 2; ++k) dst[m][k] = *(const PG8_LAS bf16x8*)(lds + PG8_SA(b, h) + aoff + m * 2048 + k * 1024); } while (0)
#define PG8_LDB(dst, b, h) do { _Pragma("unroll") for (int n = 0; n < 2; ++n) _Pragma("unroll") for (int k = 0; k < 2; ++k) dst[n][k] = *(const PG8_LAS bf16x8*)(lds + PG8_SB(b, h) + boff + n * 2048 + k * 1024); } while (0)
#define PG8_MMA(ai, bj, At, Bt) do { __builtin_amdgcn_s_setprio(1); _Pragma("unroll") for (int m = 0; m < 4; ++m) _Pragma("unroll") for (int n = 0; n < 2; ++n) _Pragma("unroll") for (int k = 0; k < 2; ++k) \
        acc[ai][bj][m][n] = __builtin_amdgcn_mfma_f32_16x16x32_bf16(Bt[n][k], At[m][k], acc[ai][bj][m][n], 0, 0, 0); __builtin_amdgcn_s_setprio(0); } while (0)
#define PG8_WAIT_V(n) asm volatile("s_waitcnt vmcnt(" #n ")" ::: "memory")
#define PG8_WAIT_L(n) asm volatile("s_waitcnt lgkmcnt(" #n ")" ::: "memory")
#define PG8_BAR __builtin_amdgcn_s_barrier()
#define PG8_SCHED __builtin_amdgcn_sched_barrier(0)
    Unit cur, nxt; int ui = 0;
    if (!S.next(0, cur)) return;
    f32x4 acc[2][2][4][2];
#pragma unroll
    for (int a = 0; a < 2; ++a)
#pragma unroll
        for (int b = 0; b < 2; ++b)
#pragma unroll
            for (int m = 0; m < 4; ++m)
#pragma unroll
                for (int n = 0; n < 2; ++n) acc[a][b][m][n] = (f32x4){0.f, 0.f, 0.f, 0.f};
    bf16x8 At[4][2], B0[2][2], B1[2][2];
    const char* cA = (const char*)g.A + (size_t)cur.pm * tstep; const char* cB = (const char*)g.Bt + (size_t)cur.pn * tstep;
    S.a_ready(cur);
    if constexpr (SP2) {
        PG8_STAGE(PG8_SB(0, 0), cB, voffB); PG8_STAGE(PG8_SB(0, 1), cB + hstep, voffB); PG8_STAGE(PG8_SA(0, 0), cA, voffA); PG8_STAGE(PG8_SA(0, 1), cA + hstep, voffA);
        if (wr == 1) PG8_BAR;
        PG8_WAIT_V(2); PG8_BAR;
        PG8_STAGE(PG8_SB(1, 0), cB + kstep, voffB); PG8_STAGE(PG8_SA(1, 0), cA + kstep, voffA); PG8_STAGE(PG8_SB(1, 1), cB + hstep + kstep, voffB);
        PG8_WAIT_V(6); PG8_BAR;
    } else {
        PG8_STAGE(PG8_SB(0, 0), cB, voffB); PG8_STAGE(PG8_SA(0, 0), cA, voffA); PG8_STAGE(PG8_SB(0, 1), cB + hstep, voffB); PG8_STAGE(PG8_SA(0, 1), cA + hstep, voffA);
        if (wr == 1) PG8_BAR;
        PG8_WAIT_V(4); PG8_BAR;
        PG8_STAGE(PG8_SB(1, 0), cB + kstep, voffB); PG8_STAGE(PG8_SA(1, 0), cA + kstep, voffA); PG8_STAGE(PG8_SB(1, 1), cB + hstep + kstep, voffB);
        PG8_WAIT_V(6); PG8_BAR;
    }
    for (;;) {
        const bool has_next = S.next(ui + 1, nxt);
        const char* nA = has_next ? (const char*)g.A + (size_t)nxt.pm * tstep : cA; const char* nB = has_next ? (const char*)g.Bt + (size_t)nxt.pn * tstep : cB;
        for (int t = 0; t < nt; t += 2) {
            const bool last = (t == nt - 2);
            const char* a1 = cA + (size_t)(t + 1) * kstep;
            const char* a2 = last ? nA : cA + (size_t)(t + 2) * kstep; const char* b2 = last ? nB : cB + (size_t)(t + 2) * kstep;
            const char* a3 = a2 + kstep; const char* b3 = b2 + kstep;
            if (last && has_next) S.a_ready(nxt);
            if constexpr (SP2) {
            PG8_LDB(B0, 0, 0); PG8_LDB(B1, 0, 1); PG8_SCHED; PG8_LDA(At, 0, 0); PG8_STAGE(PG8_SA(1, 1), a1 + hstep, voffA);
            PG8_WAIT_V(8); PG8_WAIT_L(0); PG8_BAR; PG8_MMA(0, 0, At, B0); PG8_MMA(0, 1, At, B1); PG8_BAR; PG8_SCHED;
            PG8_LDA(At, 0, 1); PG8_STAGE(PG8_SB(0, 0), b2, voffB); PG8_STAGE(PG8_SB(0, 1), b2 + hstep, voffB); PG8_STAGE(PG8_SA(0, 0), a2, voffA);
            PG8_WAIT_V(8); PG8_WAIT_L(0); PG8_BAR; PG8_MMA(1, 0, At, B0); PG8_MMA(1, 1, At, B1); PG8_BAR; PG8_SCHED;
            PG8_LDB(B0, 1, 0); PG8_LDB(B1, 1, 1); PG8_SCHED; PG8_LDA(At, 1, 0); PG8_STAGE(PG8_SA(0, 1), a2 + hstep, voffA);
            PG8_WAIT_V(8); PG8_WAIT_L(0); PG8_BAR; PG8_MMA(0, 0, At, B0); PG8_MMA(0, 1, At, B1); PG8_BAR; PG8_SCHED;
            PG8_LDA(At, 1, 1); PG8_STAGE(PG8_SB(1, 0), b3, voffB); PG8_STAGE(PG8_SB(1, 1), b3 + hstep, voffB); PG8_STAGE(PG8_SA(1, 0), a3, voffA);
            PG8_WAIT_V(8); PG8_WAIT_L(0); PG8_BAR; PG8_MMA(1, 0, At, B0); PG8_MMA(1, 1, At, B1); PG8_BAR; PG8_SCHED;
            } else {
            PG8_LDB(B0, 0, 0); PG8_SCHED; PG8_LDA(At, 0, 0); PG8_STAGE(PG8_SA(1, 1), a1 + hstep, voffA);
            PG8_WAIT_L(8); PG8_BAR; PG8_WAIT_L(0); PG8_MMA(0, 0, At, B0); PG8_BAR; PG8_SCHED;
            PG8_LDB(B1, 0, 1); PG8_STAGE(PG8_SB(0, 0), b2, voffB);
            PG8_BAR; PG8_WAIT_L(0); PG8_MMA(0, 1, At, B1); PG8_BAR;
            PG8_LDA(At, 0, 1); PG8_STAGE(PG8_SA(0, 0), a2, voffA);
            PG8_BAR; PG8_WAIT_L(0); PG8_MMA(1, 0, At, B0); PG8_BAR; PG8_SCHED;
            PG8_STAGE(PG8_SB(0, 1), b2 + hstep, voffB);
            PG8_WAIT_V(6); PG8_BAR; PG8_MMA(1, 1, At, B1); PG8_BAR;
            PG8_LDB(B0, 1, 0); PG8_SCHED; PG8_LDA(At, 1, 0); PG8_STAGE(PG8_SA(0, 1), a2 + hstep, voffA);
            PG8_WAIT_L(8); PG8_BAR; PG8_WAIT_L(0); PG8_MMA(0, 0, At, B0); PG8_BAR; PG8_SCHED;
            PG8_LDB(B1, 1, 1); PG8_STAGE(PG8_SB(1, 0), b3, voffB);
            PG8_BAR; PG8_WAIT_L(0); PG8_MMA(0, 1, At, B1); PG8_BAR;
            PG8_LDA(At, 1, 1); PG8_STAGE(PG8_SA(1, 0), a3, voffA);
            PG8_BAR; PG8_WAIT_L(0); PG8_MMA(1, 0, At, B0); PG8_BAR; PG8_SCHED;
            PG8_STAGE(PG8_SB(1, 1), b3 + hstep, voffB);
            PG8_WAIT_V(6); PG8_BAR; PG8_MMA(1, 1, At, B1); PG8_BAR;
            }
        }
        if constexpr (ALIGN_EPI) { if (wr == 0) PG8_BAR; }
        E(acc, cur, wr, wc, fr, fq); S.done(cur);
        if (!has_next) break;
#pragma unroll
        for (int a = 0; a < 2; ++a)
#pragma unroll
            for (int b = 0; b < 2; ++b)
#pragma unroll
                for (int m = 0; m < 4; ++m)
#pragma unroll
                    for (int n = 0; n < 2; ++n) acc[a][b][m][n] = (f32x4){0.f, 0.f, 0.f, 0.f};
        cur = nxt; cA = nA; cB = nB; ++ui;
        if constexpr (ALIGN_EPI) { if (wr == 1) PG8_BAR; }
    }
    PG8_WAIT_V(0);
    if constexpr (!ALIGN_EPI) { if (wr == 0) PG8_BAR; }
    PG8_BAR;
#undef PG8_SA
#undef PG8_SB
#undef PG8_STAGE
#undef PG8_LDA
#undef PG8_LDB
#undef PG8_MMA
#undef PG8_WAIT_V
#undef PG8_WAIT_L
#undef PG8_BAR
#undef PG8_SCHED
}
}

__device__ __forceinline__ float fast_sigmoid(float v) { return __builtin_amdgcn_rcpf(1.0f + __builtin_amdgcn_exp2f(-1.4426950408889634f * v)); }
struct EpiProj {
    static constexpr bool PERM = true;
    bf16* P; float* kmean;
    __device__ __forceinline__ void operator()(const pg8::f32x4 (&acc)[2][2][4][2], const pg8::Unit& u, int wr, int wc, int fr, int fq) const {
        const int pn = u.pn;
        const int mode = (pn >= CT_RK && pn < CT_RV) ? 1 : ((pn >= CT_RG && pn < CT_MQ) || (pn >= CT_MG && pn < CT_GR)) ? 2 : (pn >= CT_GR) ? 3 : 0;
        bf16* base = P + ((size_t)pn * M + (size_t)u.pm * 256 + wr * 64 + fr) * 256 + wc * 32 + 8 * fq;
#pragma unroll
        for (int ai = 0; ai < 2; ++ai)
#pragma unroll
            for (int m = 0; m < 4; ++m) { bf16* rowp = base + (size_t)(ai * 128 + m * 16) * 256;
#pragma unroll
                for (int bj = 0; bj < 2; ++bj) { pg8::f32x4 v0 = acc[ai][bj][m][0], v1 = acc[ai][bj][m][1];
                    if (mode == 1) { v0 = v0 * 0.08838834764831845f; v1 = v1 * 0.08838834764831845f; }
                    else if (mode >= 2) {
#pragma unroll
                        for (int e = 0; e < 4; ++e) { const float s0 = fast_sigmoid(v0[e]), s1 = fast_sigmoid(v1[e]); v0[e] = (mode == 2) ? v0[e] * s0 : s0; v1[e] = (mode == 2) ? v1[e] * s1 : s1; } }
                    pg8::u32x4 w; w.x = pg8::cvt_pk_bf16(v0[0], v0[1]); w.y = pg8::cvt_pk_bf16(v0[2], v0[3]); w.z = pg8::cvt_pk_bf16(v1[0], v1[1]); w.w = pg8::cvt_pk_bf16(v1[2], v1[3]);
                    *(pg8::u32x4*)(rowp + bj * 128) = w; } }
        if (pn >= CT_MK && pn < CT_MV) {
#pragma unroll
            for (int bj = 0; bj < 2; ++bj)
#pragma unroll
                for (int n = 0; n < 2; ++n) { pg8::f32x4 cs = (pg8::f32x4){0.f, 0.f, 0.f, 0.f};
#pragma unroll
                    for (int ai = 0; ai < 2; ++ai)
#pragma unroll
                        for (int m = 0; m < 4; ++m) cs += acc[ai][bj][m][n];
#pragma unroll
                    for (int e = 0; e < 4; ++e) { float s = cs[e]; s += __shfl_xor(s, 1); s += __shfl_xor(s, 2); s += __shfl_xor(s, 4); s += __shfl_xor(s, 8); cs[e] = s; }
                    if (fr == 0) { const int b = u.pm >> 3, j = u.pm & 7, h = (pn - CT_MK) * 2 + bj;
                        float* kp = kmean + ((size_t)(b * 8 + h) * 8 + j) * 128 + wc * 32 + 8 * fq + 4 * n;
#pragma unroll
                        for (int e = 0; e < 4; ++e) atomicAdd(kp + e, cs[e] * (1.0f / 256.0f)); } }
        }
    }
};
struct EpiYtmp {
    static constexpr bool PERM = true;
    const bf16* P; float* YT;
    __device__ __forceinline__ void operator()(const pg8::f32x4 (&acc)[2][2][4][2], const pg8::Unit& u, int wr, int wc, int fr, int fq) const {
        const int row0 = u.pm * 256 + wr * 64 + fr, c0 = wc * 32 + 8 * fq;
        const bf16* gb = P + ((size_t)(CT_GR + u.pn) * M + row0) * 256 + c0;
        float* yb = YT + (size_t)row0 * DM + u.pn * 256 + c0;
#pragma unroll
        for (int ai = 0; ai < 2; ++ai)
#pragma unroll
            for (int m = 0; m < 4; ++m)
#pragma unroll
                for (int bj = 0; bj < 2; ++bj) { const size_t ro = (size_t)(ai * 128 + m * 16);
                    const pg8::u32x4 g = *(const pg8::u32x4*)(gb + ro * 256 + bj * 128);
                    pg8::f32x4 g0 = {__uint_as_float(g.x << 16), __uint_as_float(g.x & 0xffff0000u), __uint_as_float(g.y << 16), __uint_as_float(g.y & 0xffff0000u)};
                    pg8::f32x4 g1 = {__uint_as_float(g.z << 16), __uint_as_float(g.z & 0xffff0000u), __uint_as_float(g.w << 16), __uint_as_float(g.w & 0xffff0000u)};
                    *(pg8::f32x4*)(yb + ro * DM + bj * 128) = g0 * acc[ai][bj][m][0];
                    *(pg8::f32x4*)(yb + ro * DM + bj * 128 + 4) = g1 * acc[ai][bj][m][1]; }
    }
};
struct EpiY {
    static constexpr bool PERM = true;
    const bf16* P; const float* YT; bf16* Y;
    __device__ __forceinline__ void operator()(const pg8::f32x4 (&acc)[2][2][4][2], const pg8::Unit& u, int wr, int wc, int fr, int fq) const {
        const int row0 = u.pm * 256 + wr * 64 + fr, c0 = wc * 32 + 8 * fq;
        const bf16* gb = P + ((size_t)(CT_GM + u.pn) * M + row0) * 256 + c0;
        const float* yb = YT + (size_t)row0 * DM + u.pn * 256 + c0;
        bf16* ob = Y + (size_t)row0 * DM + u.pn * 256 + c0;
#pragma unroll
        for (int ai = 0; ai < 2; ++ai)
#pragma unroll
            for (int m = 0; m < 4; ++m)
#pragma unroll
                for (int bj = 0; bj < 2; ++bj) { const size_t ro = (size_t)(ai * 128 + m * 16);
                    const pg8::u32x4 g = *(const pg8::u32x4*)(gb + ro * 256 + bj * 128);
                    pg8::f32x4 g0 = {__uint_as_float(g.x << 16), __uint_as_float(g.x & 0xffff0000u), __uint_as_float(g.y << 16), __uint_as_float(g.y & 0xffff0000u)};
                    pg8::f32x4 g1 = {__uint_as_float(g.z << 16), __uint_as_float(g.z & 0xffff0000u), __uint_as_float(g.w << 16), __uint_as_float(g.w & 0xffff0000u)};
                    const pg8::f32x4 y0 = *(const pg8::f32x4*)(yb + ro * DM + bj * 128) + g0 * acc[ai][bj][m][0];
                    const pg8::f32x4 y1 = *(const pg8::f32x4*)(yb + ro * DM + bj * 128 + 4) + g1 * acc[ai][bj][m][1];
                    pg8::u32x4 w; w.x = pg8::cvt_pk_bf16(y0[0], y0[1]); w.y = pg8::cvt_pk_bf16(y0[2], y0[3]); w.z = pg8::cvt_pk_bf16(y1[0], y1[1]); w.w = pg8::cvt_pk_bf16(y1[2], y1[3]);
                    *(pg8::u32x4*)(ob + ro * DM + bj * 128) = w; }
    }
};
struct EpiRes {
    static constexpr bool PERM = false;
    const float* Xin; float* X;
    __device__ __forceinline__ void operator()(const pg8::f32x4 (&acc)[2][2][4][2], const pg8::Unit& u, int wr, int wc, int fr, int fq) const {
        const size_t off0 = (size_t)(u.pm * 256 + wr * 64 + fr) * DM + u.pn * 256 + wc * 32 + 4 * fq;
#pragma unroll
        for (int ai = 0; ai < 2; ++ai)
#pragma unroll
            for (int m = 0; m < 4; ++m)
#pragma unroll
                for (int bj = 0; bj < 2; ++bj)
#pragma unroll
                    for (int n = 0; n < 2; ++n) { const size_t off = off0 + (size_t)(ai * 128 + m * 16) * DM + bj * 128 + n * 16;
                        *(pg8::f32x4*)(X + off) = *(const pg8::f32x4*)(Xin + off) + acc[ai][bj][m][n]; }
    }
};

__device__ __forceinline__ unsigned pk2(float lo, float hi) { return (unsigned)f2bf(lo) | ((unsigned)f2bf(hi) << 16); }
__device__ __forceinline__ void p0_transpose_item(const float* W, int K, int N, bf16* WT, LAS float* scr, int item, int lane) {
    const int nblk = N / 32, kb = item / nblk, nb = item % nblk, k0 = 64 * kb, n0 = 32 * nb;
#pragma unroll 8
    for (int i = 0; i < 32; ++i) { const int kk = 2 * i + (lane >> 5); scr[kk * 33 + (lane & 31)] = W[(size_t)(k0 + kk) * N + n0 + (lane & 31)]; }
    asm volatile("s_waitcnt lgkmcnt(0)" ::: "memory");
    const int c = lane & 7;
#pragma unroll
    for (int j = 0; j < 4; ++j) { const int n = (lane >> 3) + 8 * j; const LAS float* s = scr + (8 * c) * 33 + n;
        pg8::u32x4 o; o.x = pk2(s[0 * 33], s[1 * 33]); o.y = pk2(s[2 * 33], s[3 * 33]); o.z = pk2(s[4 * 33], s[5 * 33]); o.w = pk2(s[6 * 33], s[7 * 33]);
        *(pg8::u32x4*)(WT + (size_t)(n0 + n) * K + k0 + 8 * c) = o; }
    asm volatile("s_waitcnt lgkmcnt(0)" ::: "memory");
}


namespace moba {
typedef short bf16x8 __attribute__((ext_vector_type(8)));
typedef short s16x4 __attribute__((ext_vector_type(4)));
typedef float f32x16 __attribute__((ext_vector_type(16)));
typedef float f32x4 __attribute__((ext_vector_type(4)));
typedef unsigned u32x4 __attribute__((ext_vector_type(4)));
typedef LAS char* lptr;
constexpr int D = 128, NW = 8, QBLK = 32, KVBLK = 64, QB = NW * QBLK;
constexpr int LDP = 256;
constexpr int SHM_V = KVBLK * D * 2, SHM_K = KVBLK * D * 2;
constexpr int LDS_BYTES = 2 * SHM_V + 2 * SHM_K + NW * 64 * 4;
constexpr float SCALE = 0.08838834764831845f, THR = 8.f;
#define KSWZ(row, colB) ((row) * 256 + ((colB) ^ (((row) & 7) << 4)))
#define SBAR() __builtin_amdgcn_sched_barrier(0)
__device__ __forceinline__ int v_st(int k, int c) { const int kk = (k & ~0xC) | ((k & 4) << 1) | ((k & 8) >> 1); return ((kk >> 3) * 4 + (c >> 5)) * 512 + ((kk & 7) * 32 + (c & 31)) * 2; }
__device__ __forceinline__ int v_rd_base(int lane) { return ((lane & 3) << 3) | (((lane >> 2) & 3) << 6) | (((lane >> 4) & 1) << 5) | (((lane >> 5) & 1) << 8); }
constexpr int v_rd_off(int d0, int ks, int half) { return d0 * 512 + ks * 4096 + half * 2048; }
__device__ __forceinline__ int crow(int r, int hi) { return (r & 3) + 8 * (r >> 2) + 4 * hi; }
__device__ __forceinline__ unsigned cvtpk(float lo, float hi) { unsigned r; asm volatile("v_cvt_pk_bf16_f32 %0, %1, %2" : "=v"(r) : "v"(lo), "v"(hi)); return r; }
__device__ __forceinline__ bf16x8 load8(const bf16* p) { return *reinterpret_cast<const bf16x8*>(p); }

__device__ __forceinline__ void mask_tile(f32x16& p0, f32x16& p1, int dq) {
    const float NEG = -__builtin_inff();
#pragma unroll
    for (int r = 0; r < 16; ++r) { const int c = (r & 3) + 8 * (r >> 2);
        if (dq < c) p0[r] = NEG;
        if (dq < c + 32) p1[r] = NEG; }
}
__device__ __forceinline__ void alibi_tile(f32x16& p0, f32x16& p1, float slr) {
#pragma unroll
    for (int r = 0; r < 16; ++r) { const float c = (float)((r & 3) + 8 * (r >> 2));
        p0[r] = fmaf(slr, c, p0[r]); p1[r] = fmaf(slr, c + 32.f, p1[r]); }
}
__device__ __forceinline__ void partialSM(f32x16& p0, f32x16& p1, float nb, float& m_reg, float& mn, float& alpha) {
    float pmax = p0[0];
#pragma unroll
    for (int r = 1; r < 16; ++r) pmax = fmaxf(pmax, p0[r]);
#pragma unroll
    for (int r = 0; r < 16; ++r) pmax = fmaxf(pmax, p1[r]);
    pmax += nb;
    { auto rr = __builtin_amdgcn_permlane32_swap(__float_as_uint(pmax), __float_as_uint(pmax), false, false);
      pmax = fmaxf(__uint_as_float(rr[0]), __uint_as_float(rr[1])); }
    constexpr float C2 = 1.4426950408889634f * SCALE;
    if (__builtin_expect(__all((pmax - m_reg) * SCALE <= THR), 1)) { mn = m_reg; alpha = 1.f; }
    else { mn = fmaxf(m_reg, pmax); alpha = __builtin_amdgcn_exp2f((m_reg - mn) * C2); m_reg = mn; }
    const float mnL = (nb - mn) * C2;
#pragma unroll
    for (int r = 0; r < 16; ++r) p0[r] = fmaf(p0[r], C2, mnL);
#pragma unroll
    for (int r = 0; r < 16; ++r) p1[r] = fmaf(p1[r], C2, mnL);
#pragma unroll
    for (int r = 0; r < 16; ++r) p0[r] = __builtin_amdgcn_exp2f(p0[r]);
}
__device__ __forceinline__ void finishSM(f32x16& p0, f32x16& p1, float alpha, float& l_reg, bf16x8& pa0, bf16x8& pa1, bf16x8& pa2, bf16x8& pa3) {
#pragma unroll
    for (int r = 0; r < 16; ++r) p1[r] = __builtin_amdgcn_exp2f(p1[r]);
    float ps = 0;
#pragma unroll
    for (int r = 0; r < 16; ++r) ps += p0[r];
#pragma unroll
    for (int r = 0; r < 16; ++r) ps += p1[r];
    { auto rr = __builtin_amdgcn_permlane32_swap(__float_as_uint(ps), __float_as_uint(ps), false, false);
      ps = __uint_as_float(rr[0]) + __uint_as_float(rr[1]); }
    l_reg = l_reg * alpha + ps;
#define PK4(P, B_, OUT) do { unsigned a0 = cvtpk(P[B_+0], P[B_+1]), a1 = cvtpk(P[B_+2], P[B_+3]);                          \
        unsigned b0 = cvtpk(P[B_+4], P[B_+5]), b1 = cvtpk(P[B_+6], P[B_+7]);                                             \
        auto r0 = __builtin_amdgcn_permlane32_swap(a0, b0, false, false); auto r1 = __builtin_amdgcn_permlane32_swap(a1, b1, false, false); \
        u32x4 w = {r0[0], r1[0], r0[1], r1[1]}; OUT = *reinterpret_cast<bf16x8*>(&w); } while (0)
    PK4(p0, 0, pa0); PK4(p0, 8, pa1); PK4(p1, 0, pa2); PK4(p1, 8, pa3);
#undef PK4
}
template <int KB>
__device__ __forceinline__ void qkt(f32x16& p0, f32x16& p1, lptr K_lds, int r32, int hi, const bf16x8* qr) {
    p0 = f32x16{}; p1 = f32x16{};
    lptr kb[4];
#pragma unroll
    for (int dd = 0; dd < 4; ++dd) kb[dd] = K_lds + KB * SHM_K + KSWZ(r32, (dd * 16 + hi * 8) * 2);
#pragma unroll
    for (int d0 = 0; d0 < 8; ++d0) { lptr a = kb[d0 & 3] + (d0 >> 2) * 128;
        bf16x8 b0 = *(const LAS bf16x8*)(a);
        bf16x8 b1 = *(const LAS bf16x8*)(a + 32 * 256);
        p0 = __builtin_amdgcn_mfma_f32_32x32x16_bf16(b0, qr[d0], p0, 0, 0, 0);
        p1 = __builtin_amdgcn_mfma_f32_32x32x16_bf16(b1, qr[d0], p1, 0, 0, 0); }
}
template <int VB>
__device__ __forceinline__ void pv_tile(f32x16* o, int vb0, bf16x8 pa0, bf16x8 pa1, bf16x8 pa2, bf16x8 pa3) {
#define TRRD(dst, off) asm volatile("ds_read_b64_tr_b16 %0, %1 offset:%2" : "=&v"(dst) : "v"(vb0), "i"(off) : "memory")
#define PV_D0(d0) do { s16x4 l0, l1, l2, l3, h0, h1, h2, h3; constexpr int b_ = VB * SHM_V + v_rd_off(d0, 0, 0); \
        TRRD(l0, b_); TRRD(h0, b_ + 2048); TRRD(l1, b_ + 4096); TRRD(h1, b_ + 6144); TRRD(l2, b_ + 8192); TRRD(h2, b_ + 10240); TRRD(l3, b_ + 12288); TRRD(h3, b_ + 14336); \
        asm volatile("s_waitcnt lgkmcnt(0)" ::: "memory"); SBAR();   \
        o[d0] = __builtin_amdgcn_mfma_f32_32x32x16_bf16(pa0, (bf16x8){l0[0], l0[1], l0[2], l0[3], h0[0], h0[1], h0[2], h0[3]}, o[d0], 0, 0, 0);   \
        o[d0] = __builtin_amdgcn_mfma_f32_32x32x16_bf16(pa1, (bf16x8){l1[0], l1[1], l1[2], l1[3], h1[0], h1[1], h1[2], h1[3]}, o[d0], 0, 0, 0);   \
        o[d0] = __builtin_amdgcn_mfma_f32_32x32x16_bf16(pa2, (bf16x8){l2[0], l2[1], l2[2], l2[3], h2[0], h2[1], h2[2], h2[3]}, o[d0], 0, 0, 0);   \
        o[d0] = __builtin_amdgcn_mfma_f32_32x32x16_bf16(pa3, (bf16x8){l3[0], l3[1], l3[2], l3[3], h3[0], h3[1], h3[2], h3[3]}, o[d0], 0, 0, 0); } while (0)
    PV_D0(0); PV_D0(1); PV_D0(2); PV_D0(3);
#undef PV_D0
#undef TRRD
}

struct BlockRef { const bf16* Q; const bf16* K; const bf16* V; const bf16* Gt; bf16* O; const float* km; int P0; float slr; };
struct Seam { bf16x8 qr[8]; bf16x8 st_v0, st_v1, st_k0, st_k1; };
#define ROW(p, k0, rr) ((p) + (size_t)((k0) + (rr)) * LDP + sc)
#define VMW() asm volatile("s_waitcnt vmcnt(0)" ::: "memory")
#define VMWN(n) asm volatile("s_waitcnt vmcnt(%0)" :: "i"(n) : "memory")
#define SLOAD_H(Kp, Vp, k0) do { S.st_v0 = load8(ROW(Vp, k0, sr)); S.st_v1 = load8(ROW(Vp, k0, 32 + sr));              \
                         S.st_k0 = load8(ROW(Kp, k0, sr)); S.st_k1 = load8(ROW(Kp, k0, 32 + sr)); } while (0)
#define SWRITE_HK(bf) do { *(LAS bf16x8*)(K_lds + (bf) * SHM_K + kws) = S.st_k0; *(LAS bf16x8*)(K_lds + (bf) * SHM_K + kws + 32 * 256) = S.st_k1; } while (0)
#define SWRITE_HV(bf) do { *(LAS bf16x8*)(V_lds + (bf) * SHM_V + vst0) = S.st_v0; *(LAS bf16x8*)(V_lds + (bf) * SHM_V + vst1) = S.st_v1; } while (0)
#define SWRITE_H(bf) do { SWRITE_HV(bf); SWRITE_HK(bf); } while (0)
__device__ __forceinline__ int first_kb(int P0) { return P0 + QB - KVBLK; }
__device__ __forceinline__ void prime(const BlockRef& cur, lptr lds, Seam& S) {
    const int tid = otid(), wid = __builtin_amdgcn_readfirstlane(tid >> 6), lane = tid & 63, r32 = lane & 31, hi = lane >> 5;
    const int sr = tid >> 4, sc = (tid & 15) * 8, kws = KSWZ(sr, sc * 2); lptr K_lds = lds + 2 * SHM_V;
    const int kb0 = first_kb(cur.P0);
#pragma unroll
    for (int d0 = 0; d0 < 8; ++d0) S.qr[d0] = load8(cur.Q + (size_t)(wid * QBLK + r32) * LDP + d0 * 16 + hi * 8);
    SLOAD_H(cur.K, cur.V, kb0); VMW(); SWRITE_HK(0);
    __syncthreads();
}
__device__ __forceinline__ unsigned block_choice(const BlockRef& cur, const bf16x8* qr, int r32, int hi) {
    const int qb = cur.P0 >> 8;
    f32x16 g = f32x16{};
    const float* kr = cur.km + (size_t)(r32 & 7) * D + hi * 8;
#pragma unroll
    for (int d0 = 0; d0 < 8; ++d0) {
        const f32x4 a = *(const f32x4*)(kr + d0 * 16), b = *(const f32x4*)(kr + d0 * 16 + 4);
        u32x4 wh = {cvtpk(a[0], a[1]), cvtpk(a[2], a[3]), cvtpk(b[0], b[1]), cvtpk(b[2], b[3])};
        f32x4 ra, rb;
        ra[0] = a[0] - __uint_as_float(wh.x << 16); ra[1] = a[1] - __uint_as_float(wh.x & 0xffff0000u); ra[2] = a[2] - __uint_as_float(wh.y << 16); ra[3] = a[3] - __uint_as_float(wh.y & 0xffff0000u);
        rb[0] = b[0] - __uint_as_float(wh.z << 16); rb[1] = b[1] - __uint_as_float(wh.z & 0xffff0000u); rb[2] = b[2] - __uint_as_float(wh.w << 16); rb[3] = b[3] - __uint_as_float(wh.w & 0xffff0000u);
        u32x4 wl = {cvtpk(ra[0], ra[1]), cvtpk(ra[2], ra[3]), cvtpk(rb[0], rb[1]), cvtpk(rb[2], rb[3])};
        g = __builtin_amdgcn_mfma_f32_32x32x16_bf16(*reinterpret_cast<bf16x8*>(&wh), qr[d0], g, 0, 0, 0);
        g = __builtin_amdgcn_mfma_f32_32x32x16_bf16(*reinterpret_cast<bf16x8*>(&wl), qr[d0], g, 0, 0, 0);
    }
    float gt[8];
#pragma unroll
    for (int j = 0; j < 4; ++j) { auto rr = __builtin_amdgcn_permlane32_swap(__float_as_uint(g[j]), __float_as_uint(g[j]), false, false);
        gt[j] = __uint_as_float(rr[0]); gt[4 + j] = __uint_as_float(rr[1]); }
    unsigned sel = 0u;
#pragma unroll
    for (int j = 0; j < 8; ++j) { int rank = 0;
#pragma unroll
        for (int j2 = 0; j2 < 8; ++j2) if (j2 != j) rank += (j2 < qb && (gt[j2] > gt[j] || (gt[j2] == gt[j] && j2 < j))) ? 1 : 0;
        if (j < qb && rank < 3) sel |= 1u << j; }
    return sel;
}
__device__ __forceinline__ void block(const BlockRef& cur, const BlockRef& nxt, lptr lds, Seam& S) {
    const int tid = otid(), wid = __builtin_amdgcn_readfirstlane(tid >> 6), lane = tid & 63, r32 = lane & 31, hi = lane >> 5;
    const int NT = (cur.P0 + QB) / KVBLK;
    const int qb = cur.P0 >> 8;
    const int kbn = first_kb(nxt.P0);
    const int qlo = cur.P0 + wid * QBLK, qm = qlo + r32 - 4 * hi;
    lptr V_lds = lds; lptr K_lds = lds + 2 * SHM_V;
    LAS float* ws = (LAS float*)(lds + 2 * SHM_V + 2 * SHM_K) + wid * 64; LAS float* li_l = ws; LAS float* al_l = ws + 32;
    float m_reg = -1e30f, l_reg = 0; f32x16 o[4] = {};
    const int sr = tid >> 4, sc = (tid & 15) * 8, vst0 = v_st(sr, sc), vst1 = v_st(32 + sr, sc), kws = KSWZ(sr, sc * 2);
    const int vb0 = (int)(unsigned)(uintptr_t)V_lds + v_rd_base(lane);
    const bf16* Kh = cur.K; const bf16* Vh = cur.V;
    const float slr = cur.slr;
#define RESC(a) do { if (__any((a) < 1.f)) { if (hi == 0) al_l[r32] = (a); asm volatile("s_waitcnt lgkmcnt(0)" ::: "memory");              \
                     for (int d_ = 0; d_ < 4; ++d_) for (int r = 0; r < 16; ++r) o[d_][r] *= al_l[crow(r, hi)]; } } while (0)
#define KBASE(t) ((NT - 1 - (t)) * KVBLK)
#define FIXT(P0_, P1_, t, NB) do { const int kb_ = KBASE(t); alibi_tile(P0_, P1_, slr);                                                \
        NB = -slr * (float)(qm - kb_);                                                                                               \
        if ((t) < 4) { if (kb_ + KVBLK - 1 > qlo) mask_tile(P0_, P1_, qm - kb_); }                                                     \
        else { if (((sel >> (kb_ >> 8)) & 1u) == 0u) NB = -__builtin_inff(); } } while (0)
    f32x16 pA0, pA1, pB0, pB1; float mnA, mnB, alA, alB, nbA, nbB; bf16x8 pa0, pa1, pa2, pa3;
    SWRITE_HV(0); SBAR();
    SLOAD_H(Kh, Vh, KBASE(1));
    SBAR();
    const unsigned sel = block_choice(cur, S.qr, r32, hi);
    SBAR(); qkt<0>(pA0, pA1, K_lds, r32, hi, S.qr);
    FIXT(pA0, pA1, 0, nbA); partialSM(pA0, pA1, nbA, m_reg, mnA, alA);
    VMW(); SWRITE_H(1);
    __syncthreads();
#define HALF_STEP(PX0, PX1, mnX, alX, nbX, PY0, PY1, alY, t, KB, VB, SB) do {                                                      \
        SBAR(); qkt<KB>(PX0, PX1, K_lds, r32, hi, S.qr);                                                                      \
        finishSM(PY0, PY1, alY, l_reg, pa0, pa1, pa2, pa3); SBAR();                                                           \
        if ((t) + 1 < NT) { SLOAD_H(Kh, Vh, KBASE((t) + 1)); SBAR(); }                                                        \
        pv_tile<VB>(o, vb0, pa0, pa1, pa2, pa3); FIXT(PX0, PX1, (t), nbX); partialSM(PX0, PX1, nbX, m_reg, mnX, alX);        \
        __syncthreads();                                                                                                      \
        if ((t) + 1 < NT) { VMW(); SWRITE_H(SB); }                                                                            \
        RESC(alX); __syncthreads(); } while (0)
    for (int t = 1; t + 1 < NT; t += 2) {
        HALF_STEP(pB0, pB1, mnB, alB, nbB, pA0, pA1, alA, t, 1, 0, 0);
        HALF_STEP(pA0, pA1, mnA, alA, nbA, pB0, pB1, alB, t + 1, 0, 1, 1);
    }
    SBAR(); qkt<1>(pB0, pB1, K_lds, r32, hi, S.qr); SBAR();
    SLOAD_H(nxt.K, nxt.V, kbn); SBAR();
#pragma unroll
    for (int d0 = 0; d0 < 8; ++d0) S.qr[d0] = load8(nxt.Q + (size_t)(wid * QBLK + r32) * LDP + d0 * 16 + hi * 8);
    SBAR();
    finishSM(pA0, pA1, alA, l_reg, pa0, pa1, pa2, pa3); SBAR();
    pv_tile<0>(o, vb0, pa0, pa1, pa2, pa3);
    FIXT(pB0, pB1, NT - 1, nbB); partialSM(pB0, pB1, nbB, m_reg, mnB, alB); __syncthreads(); RESC(alB);
    finishSM(pB0, pB1, alB, l_reg, pa0, pa1, pa2, pa3); SBAR(); pv_tile<1>(o, vb0, pa0, pa1, pa2, pa3);
    SBAR(); VMWN(8); SWRITE_HK(0); SBAR();
    if (hi == 0) li_l[r32] = l_reg; asm volatile("s_waitcnt lgkmcnt(0)" ::: "memory");
    float rli[16];
#pragma unroll
    for (int r = 0; r < 16; ++r) rli[r] = __builtin_amdgcn_rcpf(li_l[crow(r, hi)]);
    bf16* Ow = cur.O + (size_t)(wid * QBLK) * DM;
    const bf16* Gw = cur.Gt + (size_t)(wid * QBLK) * LDP;
#pragma unroll
    for (int r = 0; r < 16; ++r) { const int orow = crow(r, hi);
#pragma unroll
        for (int d0 = 0; d0 < 4; ++d0) { const float v = o[d0][r] * rli[r];
            const float vn = __shfl_xor(v, 1);
            if ((r32 & 1) == 0) { const unsigned gg = *(const unsigned*)(Gw + (size_t)orow * LDP + d0 * 32 + r32);
                *(unsigned*)(Ow + (size_t)orow * DM + d0 * 32 + r32) = cvtpk(v * __uint_as_float(gg << 16), vn * __uint_as_float(gg & 0xffff0000u)); } } }
    __syncthreads();
#undef RESC
#undef KBASE
#undef FIXT
#undef HALF_STEP
}
#undef ROW
#undef VMW
#undef VMWN
#undef SLOAD_H
#undef SWRITE_HK
#undef SWRITE_HV
#undef SWRITE_H
#undef KSWZ
#undef SBAR

__device__ __forceinline__ BlockRef make_ref(const bf16* PROJ, const float* kmean, bf16* MOG, int bh, int qb) {
    const int b = bh >> 3, h = bh & 7; BlockRef r;
    r.Q = PROJ + proj_idx(CT_MQ + (h >> 1), b * SEQ + qb * QB, (h & 1) * 128);
    r.K = PROJ + proj_idx(CT_MK + (h >> 1), b * SEQ, (h & 1) * 128);
    r.V = PROJ + proj_idx(CT_MV + (h >> 1), b * SEQ, (h & 1) * 128);
    r.Gt = PROJ + proj_idx(CT_MG + (h >> 1), b * SEQ + qb * QB, (h & 1) * 128);
    r.O = MOG + (size_t)(b * SEQ + qb * QB) * DM + h * 128;
    r.km = kmean + (size_t)bh * 8 * D;
    r.P0 = qb * QB; r.slr = exp2f(-(float)(h + 1)) * (1.0f / SCALE);
    return r;
}
__device__ __forceinline__ void phase(const bf16* PROJ, const float* kmean, bf16* MOG, lptr lds) {
    const int G = gridDim.x, bx = blockIdx.x;
    const int vcu = (G % 8 == 0) ? (bx % 8) * (G / 8) + bx / 8 : bx;
    constexpr int NITEM = 64 * 4;
    int L = vcu; if (L >= NITEM) return;
    int pass = 0;
    BlockRef cur = make_ref(PROJ, kmean, MOG, L >> 2, L & 3);
    Seam S;
    prime(cur, lds, S);
    for (;;) {
        const bool more_pass = pass == 0, more_item = L + G < NITEM, last = !more_pass && !more_item;
        int Ln = L, passn = pass + 1;
        if (!more_pass) { passn = 0; Ln = more_item ? L + G : L; }
        const int qbn = passn ? 7 - (Ln & 3) : (Ln & 3);
        const BlockRef nxt = last ? cur : make_ref(PROJ, kmean, MOG, Ln >> 2, qbn);
        block(cur, nxt, lds, S);
        if (last) break;
        cur = nxt; pass = passn; L = Ln;
    }
}
}


namespace ret {
using moba::bf16x8; using moba::s16x4; using moba::f32x16; using moba::f32x4; using moba::u32x4; using moba::lptr; using moba::crow; using moba::cvtpk; using moba::load8; using moba::v_st; using moba::v_rd_base; using moba::v_rd_off;
constexpr int CH = 128, NCH = SEQ / CH, LDP = 256, TILE = 16384;
#define KSWZ(row, colB) ((row) * 256 + ((colB) ^ (((row) & 7) << 4)))
#define SBAR() __builtin_amdgcn_sched_barrier(0)
#define TRRD(dst, vb, off) asm volatile("ds_read_b64_tr_b16 %0, %1 offset:%2" : "=&v"(dst) : "v"(vb), "i"(off) : "memory")
#define FRAG(l, h) (bf16x8){l[0], l[1], l[2], l[3], h[0], h[1], h[2], h[3]}
__device__ __forceinline__ void pvT(f32x16* o, int vb, bf16x8 pa0, bf16x8 pa1, bf16x8 pa2, bf16x8 pa3) {
#define PV_D0(d0) do { s16x4 l0, l1, l2, l3, h0, h1, h2, h3; constexpr int b_ = v_rd_off(d0, 0, 0); \
        TRRD(l0, vb, b_); TRRD(h0, vb, b_ + 2048); TRRD(l1, vb, b_ + 4096); TRRD(h1, vb, b_ + 6144); TRRD(l2, vb, b_ + 8192); TRRD(h2, vb, b_ + 10240); TRRD(l3, vb, b_ + 12288); TRRD(h3, vb, b_ + 14336); \
        asm volatile("s_waitcnt lgkmcnt(0)" ::: "memory"); SBAR();   \
        o[d0] = __builtin_amdgcn_mfma_f32_32x32x16_bf16(FRAG(l0, h0), pa0, o[d0], 0, 0, 0);   \
        o[d0] = __builtin_amdgcn_mfma_f32_32x32x16_bf16(FRAG(l1, h1), pa1, o[d0], 0, 0, 0);   \
        o[d0] = __builtin_amdgcn_mfma_f32_32x32x16_bf16(FRAG(l2, h2), pa2, o[d0], 0, 0, 0);   \
        o[d0] = __builtin_amdgcn_mfma_f32_32x32x16_bf16(FRAG(l3, h3), pa3, o[d0], 0, 0, 0); } while (0)
    PV_D0(0); PV_D0(1); PV_D0(2); PV_D0(3);
#undef PV_D0
}
__device__ __forceinline__ bf16x8 scale8(bf16x8 v, float s) {
    u32x4 w = *reinterpret_cast<u32x4*>(&v); u32x4 r;
    r.x = cvtpk(__uint_as_float(w.x << 16) * s, __uint_as_float(w.x & 0xffff0000u) * s); r.y = cvtpk(__uint_as_float(w.y << 16) * s, __uint_as_float(w.y & 0xffff0000u) * s);
    r.z = cvtpk(__uint_as_float(w.z << 16) * s, __uint_as_float(w.z & 0xffff0000u) * s); r.w = cvtpk(__uint_as_float(w.w << 16) * s, __uint_as_float(w.w & 0xffff0000u) * s);
    return *reinterpret_cast<bf16x8*>(&r);
}

__device__ __forceinline__ void state_phase(const bf16* PROJ, bf16* STATE, lptr lds) {
    const int tid = otid(), wid = __builtin_amdgcn_readfirstlane(tid >> 6), lane = tid & 63, r32 = lane & 31, hi = lane >> 5;
    const int G = gridDim.x, bx = blockIdx.x;
    const int vcu = (G % 8 == 0) ? (bx % 8) * (G / 8) + bx / 8 : bx;
    const int sr = tid >> 4, sc = (tid & 15) * 8, kst0 = v_st(sr, sc), kst1 = v_st(32 + sr, sc);
    const int vr = tid >> 3, vc = (tid & 7) * 8, vstw = v_st(vr, vc);
    const int lbase = (int)(unsigned)(uintptr_t)lds + v_rd_base(lane);
    const int ka = lbase + (wid & 3) * 512, va = lbase + 65536 + (wid >> 2) * 512;
    for (int it = vcu; it < BATCH * 4 * 4; it += G) {
        const int bh = it >> 2, sl = it & 3, b = bh >> 2, h = bh & 3;
        const float lg = log2f(1.0f - exp2f(-5.0f - (float)h)), gch = exp2f(128.0f * lg);
        const bf16* Kp = PROJ + proj_idx(CT_RK + (h >> 1), b * SEQ, (h & 1) * 128);
        const bf16* Vp = PROJ + proj_idx(CT_RV + h, b * SEQ, sl * 64);
        bf16* Sp = STATE + (size_t)bh * NCH * CH * LDP + sl * 64 + (wid >> 2) * 32 + r32;
        bf16x8 k0, k1, k2, k3, v0, v1;
#define RS_LOAD(c) do { const bf16* kp_ = Kp + (size_t)((c) * CH) * LDP + sc; const bf16* vp_ = Vp + (size_t)((c) * CH + vr) * LDP + vc; \
        k0 = load8(kp_ + (size_t)sr * LDP); k1 = load8(kp_ + (size_t)(32 + sr) * LDP); k2 = load8(kp_ + (size_t)(64 + sr) * LDP); k3 = load8(kp_ + (size_t)(96 + sr) * LDP); \
        v0 = load8(vp_); v1 = load8(vp_ + (size_t)64 * LDP); } while (0)
#define RS_WRITE(buf) do { lptr kb_ = lds + (buf) * 32768; lptr vb_ = lds + 65536 + (buf) * 32768; \
        *(LAS bf16x8*)(kb_ + kst0) = k0; *(LAS bf16x8*)(kb_ + kst1) = k1; *(LAS bf16x8*)(kb_ + TILE + kst0) = k2; *(LAS bf16x8*)(kb_ + TILE + kst1) = k3; \
        *(LAS bf16x8*)(vb_ + vstw) = scale8(v0, exp2f((float)(127 - vr) * lg)); *(LAS bf16x8*)(vb_ + TILE + vstw) = scale8(v1, exp2f((float)(63 - vr) * lg)); } while (0)
        f32x16 acc = f32x16{};
        RS_LOAD(0);
        for (int c = 0; c < NCH - 1; ++c) {
            const int buf = c & 1;
            RS_WRITE(buf);
            __syncthreads();
            if (c + 1 < NCH - 1) RS_LOAD(c + 1);
            acc = acc * gch;
#pragma unroll
            for (int kt = 0; kt < 2; ++kt) {
                const int ka_ = ka + buf * 32768 + kt * TILE, va_ = va + buf * 32768 + kt * TILE;
                s16x4 al0, al1, al2, al3, ah0, ah1, ah2, ah3, bl0, bl1, bl2, bl3, bh0, bh1, bh2, bh3;
                TRRD(al0, ka_, 0); TRRD(ah0, ka_, 2048); TRRD(al1, ka_, 4096); TRRD(ah1, ka_, 6144); TRRD(al2, ka_, 8192); TRRD(ah2, ka_, 10240); TRRD(al3, ka_, 12288); TRRD(ah3, ka_, 14336);
                TRRD(bl0, va_, 0); TRRD(bh0, va_, 2048); TRRD(bl1, va_, 4096); TRRD(bh1, va_, 6144); TRRD(bl2, va_, 8192); TRRD(bh2, va_, 10240); TRRD(bl3, va_, 12288); TRRD(bh3, va_, 14336);
                asm volatile("s_waitcnt lgkmcnt(0)" ::: "memory"); SBAR();
                acc = __builtin_amdgcn_mfma_f32_32x32x16_bf16(FRAG(al0, ah0), FRAG(bl0, bh0), acc, 0, 0, 0);
                acc = __builtin_amdgcn_mfma_f32_32x32x16_bf16(FRAG(al1, ah1), FRAG(bl1, bh1), acc, 0, 0, 0);
                acc = __builtin_amdgcn_mfma_f32_32x32x16_bf16(FRAG(al2, ah2), FRAG(bl2, bh2), acc, 0, 0, 0);
                acc = __builtin_amdgcn_mfma_f32_32x32x16_bf16(FRAG(al3, ah3), FRAG(bl3, bh3), acc, 0, 0, 0);
            }
            bf16* so = Sp + (size_t)((c + 1) * CH + (wid & 3) * 32) * LDP;
#pragma unroll
            for (int r = 0; r < 16; ++r) { const float v = acc[r], vn = __shfl_xor(v, 1);
                if ((r32 & 1) == 0) *(unsigned*)(so + (size_t)crow(r, hi) * LDP) = cvtpk(v, vn); }
        }
        __syncthreads();
#undef RS_LOAD
#undef RS_WRITE
    }
}

__device__ __forceinline__ void out_phase(const bf16* PROJ, const bf16* STATE, const float* gn_w, bf16* RETG, lptr lds, LAS float* st_l) {
    const int tid = otid(), wid = __builtin_amdgcn_readfirstlane(tid >> 6), lane = tid & 63, r32 = lane & 31, hi = lane >> 5;
    const int G = gridDim.x, bx = blockIdx.x;
    const int vcu = (G % 8 == 0) ? (bx % 8) * (G / 8) + bx / 8 : bx;
    const int qi = wid & 3, vh = wid >> 2;
    const int sr = tid >> 4, sc = (tid & 15) * 8, vst0 = v_st(sr, sc), vst1 = v_st(32 + sr, sc);
    lptr S_lds = lds; lptr V_lds = lds + 65536;
    const int sb = (int)(unsigned)(uintptr_t)S_lds + v_rd_base(lane), vb = sb + 65536;
    for (int it = vcu; it < BATCH * 4 * NCH; it += G) {
        const int bh = it >> 4, c = it & 15, b = bh >> 2, h = bh & 3;
        const float lg = log2f(1.0f - exp2f(-5.0f - (float)h));
        const int row0 = b * SEQ + c * CH;
        const bf16* Qp = PROJ + proj_idx(CT_RQ + (h >> 1), row0, (h & 1) * 128);
        const bf16* Kp = PROJ + proj_idx(CT_RK + (h >> 1), row0, (h & 1) * 128);
        const bf16* Vp = PROJ + proj_idx(CT_RV + h, row0, 0);
        const bf16* Gp = PROJ + proj_idx(CT_RG + h, row0, 0);
        const bf16* Sp = STATE + (size_t)(bh * NCH + c) * CH * LDP;
        {
            bf16x8 t0, t1, t2, t3, t4, t5, t6, t7;
            if (c > 0) {
                t0 = load8(Sp + (size_t)sr * LDP + sc);        t1 = load8(Sp + (size_t)(32 + sr) * LDP + sc);
                t2 = load8(Sp + (size_t)sr * LDP + 128 + sc);  t3 = load8(Sp + (size_t)(32 + sr) * LDP + 128 + sc);
                t4 = load8(Sp + (size_t)(64 + sr) * LDP + sc); t5 = load8(Sp + (size_t)(96 + sr) * LDP + sc);
                t6 = load8(Sp + (size_t)(64 + sr) * LDP + 128 + sc); t7 = load8(Sp + (size_t)(96 + sr) * LDP + 128 + sc);
                *(LAS bf16x8*)(S_lds + 0 * TILE + vst0) = t0; *(LAS bf16x8*)(S_lds + 0 * TILE + vst1) = t1; *(LAS bf16x8*)(S_lds + 1 * TILE + vst0) = t2; *(LAS bf16x8*)(S_lds + 1 * TILE + vst1) = t3;
                *(LAS bf16x8*)(S_lds + 2 * TILE + vst0) = t4; *(LAS bf16x8*)(S_lds + 2 * TILE + vst1) = t5; *(LAS bf16x8*)(S_lds + 3 * TILE + vst0) = t6; *(LAS bf16x8*)(S_lds + 3 * TILE + vst1) = t7;
            }
            asm volatile("" ::: "memory");
            t0 = load8(Vp + (size_t)sr * LDP + sc);        t1 = load8(Vp + (size_t)(32 + sr) * LDP + sc);
            t2 = load8(Vp + (size_t)sr * LDP + 128 + sc);  t3 = load8(Vp + (size_t)(32 + sr) * LDP + 128 + sc);
            t4 = load8(Vp + (size_t)(64 + sr) * LDP + sc); t5 = load8(Vp + (size_t)(96 + sr) * LDP + sc);
            t6 = load8(Vp + (size_t)(64 + sr) * LDP + 128 + sc); t7 = load8(Vp + (size_t)(96 + sr) * LDP + 128 + sc);
            *(LAS bf16x8*)(V_lds + 0 * TILE + vst0) = t0; *(LAS bf16x8*)(V_lds + 0 * TILE + vst1) = t1; *(LAS bf16x8*)(V_lds + 1 * TILE + vst0) = t2; *(LAS bf16x8*)(V_lds + 1 * TILE + vst1) = t3;
            *(LAS bf16x8*)(V_lds + 2 * TILE + vst0) = t4; *(LAS bf16x8*)(V_lds + 2 * TILE + vst1) = t5; *(LAS bf16x8*)(V_lds + 3 * TILE + vst0) = t6; *(LAS bf16x8*)(V_lds + 3 * TILE + vst1) = t7;
        }
        bf16x8 qr[8];
#pragma unroll
        for (int d0 = 0; d0 < 8; ++d0) qr[d0] = load8(Qp + (size_t)(qi * 32 + r32) * LDP + d0 * 16 + hi * 8);
        const int n = qi * 32 + r32;
        bf16x8 pa00, pa01, pa02, pa03, pa10, pa11, pa12, pa13;
#define PK4(P, B_, OUT) do { unsigned a0 = cvtpk(P[B_+0], P[B_+1]), a1 = cvtpk(P[B_+2], P[B_+3]);                          \
        unsigned b0 = cvtpk(P[B_+4], P[B_+5]), b1 = cvtpk(P[B_+6], P[B_+7]);                                             \
        auto r0 = __builtin_amdgcn_permlane32_swap(a0, b0, false, false); auto r1 = __builtin_amdgcn_permlane32_swap(a1, b1, false, false); \
        u32x4 w = {r0[0], r1[0], r0[1], r1[1]}; OUT = *reinterpret_cast<bf16x8*>(&w); } while (0)
#define SCORES(kt, PA0, PA1, PA2, PA3) do { f32x16 p0 = f32x16{}, p1 = f32x16{};                                          \
        if ((kt) * 64 <= qi * 32 + 31) {                                                                                    \
            const bf16* kr_ = Kp + (size_t)((kt) * 64 + r32) * LDP + hi * 8;                                                \
            _Pragma("unroll") for (int d0 = 0; d0 < 8; ++d0) { const bf16x8 b0 = load8(kr_ + d0 * 16), b1 = load8(kr_ + (size_t)32 * LDP + d0 * 16); \
                p0 = __builtin_amdgcn_mfma_f32_32x32x16_bf16(b0, qr[d0], p0, 0, 0, 0);                                      \
                p1 = __builtin_amdgcn_mfma_f32_32x32x16_bf16(b1, qr[d0], p1, 0, 0, 0); }                                    \
            const int dn0 = n - (kt) * 64 - 4 * hi;                                                                         \
            _Pragma("unroll") for (int r = 0; r < 16; ++r) { const int cr = (r & 3) + 8 * (r >> 2); const int d0_ = dn0 - cr, d1_ = dn0 - cr - 32; \
                p0[r] = d0_ >= 0 ? p0[r] * __builtin_amdgcn_exp2f((float)d0_ * lg) : 0.f;                                  \
                p1[r] = d1_ >= 0 ? p1[r] * __builtin_amdgcn_exp2f((float)d1_ * lg) : 0.f; } }                               \
        PK4(p0, 0, PA0); PK4(p0, 8, PA1); PK4(p1, 0, PA2); PK4(p1, 8, PA3); } while (0)
        SCORES(0, pa00, pa01, pa02, pa03);
        SCORES(1, pa10, pa11, pa12, pa13);
#undef SCORES
#undef PK4
        __syncthreads();
        f32x16 o[4] = {};
        if (c > 0) {
            pvT(o, sb + (0 * 2 + vh) * TILE, qr[0], qr[1], qr[2], qr[3]);
            pvT(o, sb + (1 * 2 + vh) * TILE, qr[4], qr[5], qr[6], qr[7]);
            const float xi = exp2f((float)(n + 1) * lg);
#pragma unroll
            for (int d0 = 0; d0 < 4; ++d0) o[d0] = o[d0] * xi;
        }
        pvT(o, vb + (0 * 2 + vh) * TILE, pa00, pa01, pa02, pa03);
        if (qi >= 2) pvT(o, vb + (1 * 2 + vh) * TILE, pa10, pa11, pa12, pa13);
        float s = 0.f, ss = 0.f;
#pragma unroll
        for (int d0 = 0; d0 < 4; ++d0)
#pragma unroll
            for (int r = 0; r < 16; ++r) { s += o[d0][r]; ss += o[d0][r] * o[d0][r]; }
        { auto rr = __builtin_amdgcn_permlane32_swap(__float_as_uint(s), __float_as_uint(s), false, false); s = __uint_as_float(rr[0]) + __uint_as_float(rr[1]); }
        { auto rr = __builtin_amdgcn_permlane32_swap(__float_as_uint(ss), __float_as_uint(ss), false, false); ss = __uint_as_float(rr[0]) + __uint_as_float(rr[1]); }
        if (hi == 0) { st_l[(wid * 32 + r32) * 2] = s; st_l[(wid * 32 + r32) * 2 + 1] = ss; }
        __syncthreads();
        s += st_l[((wid ^ 4) * 32 + r32) * 2]; ss += st_l[((wid ^ 4) * 32 + r32) * 2 + 1];
        const float mu = s * (1.0f / 256.0f), var = ss * (1.0f / 256.0f) - mu * mu, rs = 1.0f / sqrtf(fmaxf(var, 0.f) + NORM_EPS);
        const size_t grow = (size_t)(row0 + n);
#pragma unroll
        for (int d0 = 0; d0 < 4; ++d0) {
#pragma unroll
            for (int rg = 0; rg < 4; ++rg) {
                const int dv = vh * 128 + d0 * 32 + 8 * rg + 4 * hi;
                const f32x4 w4 = *(const f32x4*)(gn_w + h * 256 + dv);
                const uint2 g2 = *(const uint2*)(Gp + (size_t)n * LDP + dv);
                const float y0 = (o[d0][4 * rg + 0] - mu) * rs * w4[0] * __uint_as_float(g2.x << 16), y1 = (o[d0][4 * rg + 1] - mu) * rs * w4[1] * __uint_as_float(g2.x & 0xffff0000u);
                const float y2 = (o[d0][4 * rg + 2] - mu) * rs * w4[2] * __uint_as_float(g2.y << 16), y3 = (o[d0][4 * rg + 3] - mu) * rs * w4[3] * __uint_as_float(g2.y & 0xffff0000u);
                uint2 ov; ov.x = cvtpk(y0, y1); ov.y = cvtpk(y2, y3);
                *(uint2*)(RETG + grow * DM + h * 256 + dv) = ov;
            }
            asm volatile("" ::: "memory");
        }
        __syncthreads();
    }
}
#undef KSWZ
#undef SBAR
#undef TRRD
#undef FRAG
}

__device__ __forceinline__ void ph_rmsnorm(const float* X, const float* w, bf16* XN, float* OUT) {
    const int tid_ = otid(), lane = tid_ & 63, wave = tid_ >> 6;
    for (int row = blockIdx.x * NWAVES + wave; row < M; row += gridDim.x * NWAVES) {
        const f32x4* xr = (const f32x4*)(X + (size_t)row * DM) + lane;
        f32x4 v[4]; float ss = 0.f;
#pragma unroll
        for (int j = 0; j < 4; ++j) { v[j] = xr[64 * j]; ss += v[j].x * v[j].x + v[j].y * v[j].y + v[j].z * v[j].z + v[j].w * v[j].w; }
        ss = wave_sum(ss);
        const float rstd = 1.0f / sqrtf(ss * (1.0f / DM) + NORM_EPS);
#pragma unroll
        for (int j = 0; j < 4; ++j) {
            const int col = (lane + 64 * j) * 4; const f32x4 w4 = *(const f32x4*)(w + col);
            const f32x4 o = v[j] * rstd * w4;
            if (XN) { uint2 pk; pk.x = (unsigned)f2bf(o.x) | ((unsigned)f2bf(o.y) << 16); pk.y = (unsigned)f2bf(o.z) | ((unsigned)f2bf(o.w) << 16); *(uint2*)(XN + (size_t)row * DM + col) = pk; }
            if (OUT) *(f32x4*)(OUT + (size_t)row * DM + col) = o;
        }
    }
}

template <class EP>
__device__ __forceinline__ void ngemm(const bf16* A, int lda, const float* W, int N, int K, EP ep) {
    const int lane = threadIdx.x & 63, wave = threadIdx.x >> 6, r32 = lane & 31, h = lane >> 5;
    const int ntn = N / 32, ntm = M / 32, NWG = gridDim.x * NWAVES;
    for (int t = blockIdx.x * NWAVES + wave; t < ntm * ntn; t += NWG) {
        const int mt = t / ntn, nt = t % ntn;
        f32x16 acc = {};
        const bf16* ap = A + (size_t)(mt * 32 + r32) * lda + 4 * h;
        const float* wp = W + (size_t)(4 * h) * N + nt * 32 + r32;
        for (int k0 = 0; k0 < K; k0 += 8) {
            const uint2 a2 = *(const uint2*)(ap + k0);
            const float a0 = __uint_as_float(a2.x << 16), a1 = __uint_as_float(a2.x & 0xffff0000u), a2f = __uint_as_float(a2.y << 16), a3 = __uint_as_float(a2.y & 0xffff0000u);
            const float b0 = wp[(size_t)(k0 + 0) * N], b1 = wp[(size_t)(k0 + 1) * N], b2 = wp[(size_t)(k0 + 2) * N], b3 = wp[(size_t)(k0 + 3) * N];
            acc = __builtin_amdgcn_mfma_f32_32x32x2f32(a0, b0, acc, 0, 0, 0);
            acc = __builtin_amdgcn_mfma_f32_32x32x2f32(a1, b1, acc, 0, 0, 0);
            acc = __builtin_amdgcn_mfma_f32_32x32x2f32(a2f, b2, acc, 0, 0, 0);
            acc = __builtin_amdgcn_mfma_f32_32x32x2f32(a3, b3, acc, 0, 0, 0);
        }
#pragma unroll
        for (int r = 0; r < 16; ++r) ep(mt * 32 + (r & 3) + 8 * (r >> 2) + 4 * h, nt * 32 + r32, acc[r]);
    }
}

__device__ __forceinline__ void ph_kmean(const bf16* PROJ, float* kmean) {
    for (int o = blockIdx.x * NTHR + otid(); o < BATCH * 8 * 8 * 128; o += gridDim.x * NTHR) {
        const int d = o & 127, j = (o >> 7) & 7, h = (o >> 10) & 7, b = o >> 13;
        const bf16* p = PROJ + proj_idx(CT_MK + (h >> 1), b * SEQ + j * 256, (h & 1) * 128 + d);
        float s = 0.f;
        for (int k = 0; k < 256; ++k) s += bf2f(p[(size_t)k * 256]);
        kmean[o] = s * (1.0f / 256.0f);
    }
}

__device__ __forceinline__ void ph_moba_naive(const bf16* PROJ, const float* kmean, bf16* MOG, float* lds) {
    float* qs = lds;
    float* ks = qs + 32 * 132;
    float* vs = ks + 64 * 132;
    float* ss = vs + 64 * 128;
    const int tid = otid(), q = tid >> 4, part = tid & 15;
    const float scale = 0.08838834764831845f;
    for (int item = blockIdx.x; item < 64 * 64; item += gridDim.x) {
        const int bh = item >> 6, qt = item & 63, b = bh >> 3, h = bh & 7, qb = qt >> 3, t0 = qt * 32;
        const bf16* Qp = PROJ + proj_idx(CT_MQ + (h >> 1), b * SEQ, (h & 1) * 128);
        const bf16* Kp = PROJ + proj_idx(CT_MK + (h >> 1), b * SEQ, (h & 1) * 128);
        const bf16* Vp = PROJ + proj_idx(CT_MV + (h >> 1), b * SEQ, (h & 1) * 128);
        const bf16* Gp = PROJ + proj_idx(CT_MG + (h >> 1), b * SEQ, (h & 1) * 128);
        for (int i = tid; i < 32 * 128; i += NTHR) { const int r = i >> 7, d = i & 127; qs[r * 132 + d] = bf2f(Qp[(size_t)(t0 + r) * 256 + d]); }
        __syncthreads();
        float g[8];
#pragma unroll
        for (int j = 0; j < 8; ++j) {
            float s = 0.f;
            if (j < qb) { const float* km = kmean + ((size_t)(b * 8 + h) * 8 + j) * 128 + part * 8;
#pragma unroll
                for (int d = 0; d < 8; ++d) s += qs[q * 132 + part * 8 + d] * km[d]; }
            s += __shfl_xor(s, 1); s += __shfl_xor(s, 2); s += __shfl_xor(s, 4); s += __shfl_xor(s, 8);
            g[j] = s;
        }
        unsigned sel = 0u;
#pragma unroll
        for (int j = 0; j < 8; ++j) { if (j < qb) { int rank = 0;
#pragma unroll
                for (int j2 = 0; j2 < 8; ++j2) if (j2 < qb && (g[j2] > g[j] || (g[j2] == g[j] && j2 < j))) ++rank;
                if (rank < 3) sel |= 1u << j; } }
        float m = -1e30f, l = 0.f, O[8];
#pragma unroll
        for (int d = 0; d < 8; ++d) O[d] = 0.f;
        const float slope = exp2f(-(float)(h + 1));
        const int t = t0 + q;
        for (int kt = 0; kt < 4 * (qb + 1); ++kt) {
            const int kb = kt * 64, jb = kt >> 2;
            for (int i = tid; i < 64 * 128; i += NTHR) { const int r = i >> 7, d = i & 127; ks[r * 132 + d] = bf2f(Kp[(size_t)(kb + r) * 256 + d]); vs[r * 128 + d] = bf2f(Vp[(size_t)(kb + r) * 256 + d]); }
            __syncthreads();
#pragma unroll
            for (int i = 0; i < 4; ++i) {
                const int key = part * 4 + i; float s = 0.f;
                for (int d = 0; d < 128; ++d) s += qs[q * 132 + d] * ks[key * 132 + d];
                const int dist = t - (kb + key);
                const bool allowed = (jb == qb) ? (dist >= 0) : (((sel >> jb) & 1u) != 0u);
                ss[q * 64 + key] = allowed ? (s * scale - slope * (float)dist) : -__builtin_inff();
            }
            __syncthreads();
            float rm = -__builtin_inff();
            for (int k = 0; k < 64; ++k) rm = fmaxf(rm, ss[q * 64 + k]);
            const float mn = fmaxf(m, rm), alpha = expf(m - mn);
            float ps = 0.f;
#pragma unroll
            for (int d = 0; d < 8; ++d) O[d] *= alpha;
            for (int k = 0; k < 64; ++k) { const float p = expf(ss[q * 64 + k] - mn); ps += p;
#pragma unroll
                for (int d = 0; d < 8; ++d) O[d] += p * vs[k * 128 + part * 8 + d]; }
            l = l * alpha + ps; m = mn;
            __syncthreads();
        }
        const float inv = 1.0f / l;
#pragma unroll
        for (int d = 0; d < 8; ++d) {
            const float gt = bf2f(Gp[(size_t)t * 256 + part * 8 + d]);
            MOG[(size_t)(b * SEQ + t) * DM + h * 128 + part * 8 + d] = f2bf(O[d] * inv * gt);
        }
        __syncthreads();
    }
}

__device__ __forceinline__ void ph_ret_naive(const bf16* PROJ, const float* gn_w, bf16* RETG, float* lds) {
    constexpr int CH = 8;
    float* qs = lds;
    float* ks = qs + CH * 128;
    float* vs = ks + CH * 128;
    float* ot = vs + CH * 256;
    const int tid = otid(), col = tid & 255, half = tid >> 8, lane = tid & 63, wave = tid >> 6;
    for (int bh = blockIdx.x; bh < BATCH * 4; bh += gridDim.x) {
        const int b = bh >> 2, h = bh & 3;
        const float gamma = 1.0f - exp2f(-5.0f - (float)h);
        const bf16* Qp = PROJ + proj_idx(CT_RQ + (h >> 1), b * SEQ, (h & 1) * 128);
        const bf16* Kp = PROJ + proj_idx(CT_RK + (h >> 1), b * SEQ, (h & 1) * 128);
        const bf16* Vp = PROJ + proj_idx(CT_RV + h, b * SEQ, 0);
        const bf16* Gp = PROJ + proj_idx(CT_RG + h, b * SEQ, 0);
        float S[64];
#pragma unroll
        for (int i = 0; i < 64; ++i) S[i] = 0.f;
        for (int c0 = 0; c0 < SEQ; c0 += CH) {
            for (int i = tid; i < CH * 128; i += NTHR) { const int r = i >> 7, d = i & 127; qs[i] = bf2f(Qp[(size_t)(c0 + r) * 256 + d]); ks[i] = bf2f(Kp[(size_t)(c0 + r) * 256 + d]); }
            for (int i = tid; i < CH * 256; i += NTHR) { const int r = i >> 8, c = i & 255; vs[i] = bf2f(Vp[(size_t)(c0 + r) * 256 + c]); }
            __syncthreads();
#pragma unroll 1
            for (int n = 0; n < CH; ++n) {
                float acc = 0.f; const float vn = vs[n * 256 + col];
                const float* kr = ks + n * 128 + half * 64; const float* qr = qs + n * 128 + half * 64;
#pragma unroll
                for (int d = 0; d < 64; ++d) { S[d] = gamma * S[d] + kr[d] * vn; acc += qr[d] * S[d]; }
                ot[(half * CH + n) * 256 + col] = acc;
            }
            __syncthreads();
            {
                const int n = wave; f32x4 x = *(const f32x4*)&ot[n * 256 + lane * 4]; x += *(const f32x4*)&ot[(CH + n) * 256 + lane * 4];
                const float mu = wave_sum(x.x + x.y + x.z + x.w) * (1.0f / 256.0f);
                const f32x4 dx = x - mu;
                const float var = wave_sum(dx.x * dx.x + dx.y * dx.y + dx.z * dx.z + dx.w * dx.w) * (1.0f / 256.0f);
                const float rs = 1.0f / sqrtf(var + NORM_EPS);
                const int row = b * SEQ + c0 + n;
#pragma unroll
                for (int e = 0; e < 4; ++e) { const int c = lane * 4 + e;
                    const float gt = bf2f(Gp[(size_t)(c0 + n) * 256 + c]);
                    RETG[(size_t)row * DM + h * 256 + c] = f2bf(dx[e] * rs * gn_w[h * 256 + c] * gt); }
            }
            __syncthreads();
        }
    }
}

constexpr int LDS_BYTES = 147456, LDSCTL_OFF = 131072;
struct Args { const float* x; const float* ln_w; const float* w_in; const float* gn_w; const float* w_ro; const float* w_mo; const float* w_out; const float* fn_w;
              float* out; unsigned char* ws; int st_lo, st_hi; };
constexpr int STEPS_PER_LAYER = 6, NSTEPS = 1 + DEPTH * STEPS_PER_LAYER;
constexpr int IT_WIN = (DM / 64) * (D_IN / 32), IT_SQ = (DM / 64) * (DM / 32);

typedef __attribute__((address_space(4))) const Args* ArgsP;
#define ARGP() ({ ArgsP _p = (ArgsP)__builtin_amdgcn_kernarg_segment_ptr(); asm volatile("" : "+s"(_p)); _p; })
__global__ void __launch_bounds__(NTHR, 2) hybrid_fwd(Args a_unused) {
    extern __shared__ __attribute__((aligned(16))) unsigned char lds[];
    const int tid = threadIdx.x;
    LAS unsigned char* lds3 = (LAS unsigned char*)lds;
    {
        volatile LAS unsigned* MISC0 = (volatile LAS unsigned*)(lds3 + LDSCTL_OFF);
        for (int u = tid; u < (LDS_BYTES - LDSCTL_OFF) / 4; u += NTHR) MISC0[u] = 0u;
    }
    __syncthreads();
    XcdBarrier bar;
    { ArgsP ap = ARGP(); bar = xcd_barrier_post((unsigned*)(ap->ws + WS_CTL) + CW_BAR, (volatile LAS unsigned*)(lds3 + LDSCTL_OFF) + 8); }
    const int st_lo = ARGP()->st_lo, st_hi = ARGP()->st_hi;

#pragma unroll 1
    for (int st = st_lo; st < st_hi; ++st) {
        ArgsP ap = ARGP();
        unsigned char* ws = ap->ws;
        const int G = gridDim.x;
        if (st == 0) {
            const int tid2 = otid(), lane = tid2 & 63, wave = __builtin_amdgcn_readfirstlane(tid2 >> 6);
            LAS float* scr = (LAS float*)(lds3 + wave * 16384);
            const int gw = blockIdx.x * NWAVES + wave, NGW = G * NWAVES;
            constexpr int PER_L = IT_WIN + 3 * IT_SQ;
            bf16* WIN = (bf16*)(ws + WS_WIN); bf16* WRO = (bf16*)(ws + WS_WRO); bf16* WMO = (bf16*)(ws + WS_WMO); bf16* WOUT = (bf16*)(ws + WS_WOUT);
            for (int it = gw; it < DEPTH * PER_L; it += NGW) {
                const int l = it / PER_L; int r = it % PER_L;
                if (r < IT_WIN) { p0_transpose_item(ap->w_in + (size_t)l * DM * D_IN, DM, D_IN, WIN + (size_t)l * D_IN * DM, scr, r, lane); continue; } r -= IT_WIN;
                if (r < IT_SQ) { p0_transpose_item(ap->w_ro + (size_t)l * DM * DM, DM, DM, WRO + (size_t)l * DM * DM, scr, r, lane); continue; } r -= IT_SQ;
                if (r < IT_SQ) { p0_transpose_item(ap->w_mo + (size_t)l * DM * DM, DM, DM, WMO + (size_t)l * DM * DM, scr, r, lane); continue; } r -= IT_SQ;
                p0_transpose_item(ap->w_out + (size_t)l * DM * DM, DM, DM, WOUT + (size_t)l * DM * DM, scr, r, lane);
            }
            ph_rmsnorm(ap->x, ap->ln_w, (bf16*)(ws + WS_XN), nullptr);
        } else {
            const int layer = (st - 1) / STEPS_PER_LAYER, p = (st - 1) % STEPS_PER_LAYER;
            if (p == 0) {
                pg8::Gemm g{(const bf16*)(ws + WS_XN), (const bf16*)(ws + WS_WIN) + (size_t)layer * D_IN * DM, M, D_IN, DM}; pg8::StaticOrder S; S.init(M, D_IN, G, (int)blockIdx.x);
                EpiProj E{(bf16*)(ws + WS_PROJ), (float*)(ws + WS_KMEAN) + (size_t)layer * (BATCH * 8 * 8 * 128)};
                pg8::gemm_phase<EpiProj, pg8::StaticOrder, true, true>(lds3, g, S, E);
            } else if (p == 1) {
                ret::state_phase((const bf16*)(ws + WS_PROJ), (bf16*)(ws + WS_XN), (moba::lptr)lds3);
                __syncthreads();
                moba::phase((const bf16*)(ws + WS_PROJ), (const float*)(ws + WS_KMEAN) + (size_t)layer * (BATCH * 8 * 8 * 128), (bf16*)(ws + WS_MOG), (moba::lptr)lds3);
            } else if (p == 2) {
                ret::out_phase((const bf16*)(ws + WS_PROJ), (const bf16*)(ws + WS_XN), ap->gn_w + layer * DM, (bf16*)(ws + WS_RETG), (moba::lptr)lds3, (LAS float*)(lds3 + LDSCTL_OFF + 1024));
            } else if (p == 3) {
                { pg8::Gemm g{(const bf16*)(ws + WS_RETG), (const bf16*)(ws + WS_WRO) + (size_t)layer * DM * DM, M, DM, DM}; pg8::StaticOrder S; S.init(M, DM, G, (int)blockIdx.x);
                  EpiYtmp E{(const bf16*)(ws + WS_PROJ), (float*)(ws + WS_YTMP)}; pg8::gemm_phase<EpiYtmp, pg8::StaticOrder, false, true>(lds3, g, S, E); }
                { pg8::Gemm g{(const bf16*)(ws + WS_MOG), (const bf16*)(ws + WS_WMO) + (size_t)layer * DM * DM, M, DM, DM}; pg8::StaticOrder S; S.init(M, DM, G, (int)blockIdx.x);
                  EpiY E{(const bf16*)(ws + WS_PROJ), (const float*)(ws + WS_YTMP), (bf16*)(ws + WS_Y)}; pg8::gemm_phase<EpiY, pg8::StaticOrder, false, true>(lds3, g, S, E); }
            } else if (p == 4) {
                pg8::Gemm g{(const bf16*)(ws + WS_Y), (const bf16*)(ws + WS_WOUT) + (size_t)layer * DM * DM, M, DM, DM}; pg8::StaticOrder S; S.init(M, DM, G, (int)blockIdx.x);
                EpiRes E{(layer == 0) ? ap->x : (const float*)(ws + WS_X), (float*)(ws + WS_X)}; pg8::gemm_phase<EpiRes, pg8::StaticOrder, false, true>(lds3, g, S, E);
            } else {
                if (layer + 1 < DEPTH) ph_rmsnorm((const float*)(ws + WS_X), ap->ln_w + (layer + 1) * DM, (bf16*)(ws + WS_XN), nullptr);
                else ph_rmsnorm((const float*)(ws + WS_X), ap->fn_w, nullptr, ap->out);
            }
        }
        if (st + 1 < st_hi) xcd_barrier(bar);
    }
}

extern "C" void kernel_launch(void* const* d_in, const int* in_sizes, int n_in, void* d_out, int out_size, void* d_ws, size_t ws_size, hipStream_t stream) {
    static int grid = 0;
    if (grid == 0) {
        if (n_in != 8 || in_sizes[0] != M * DM || out_size != M * DM || ws_size < WS_END) {
            fprintf(stderr, "kernel_launch: unexpected shapes / workspace (n_in %d, in0 %d, out %d, ws %zu, need %zu)\n", n_in, n_in > 0 ? in_sizes[0] : -1, out_size, ws_size, (size_t)WS_END);
            grid = -1; return; }
        int dev = 0, cus = 0;
        if (hipGetDevice(&dev) != hipSuccess || hipDeviceGetAttribute(&cus, hipDeviceAttributeMultiprocessorCount, dev) != hipSuccess || cus <= 0) { grid = -1; return; }
        if (hipFuncSetAttribute((const void*)hybrid_fwd, hipFuncAttributeMaxDynamicSharedMemorySize, LDS_BYTES) != hipSuccess) { fprintf(stderr, "kernel_launch: hipFuncSetAttribute failed\n"); grid = -1; return; }
        int per_cu = 0;
        if (hipOccupancyMaxActiveBlocksPerMultiprocessor(&per_cu, (const void*)hybrid_fwd, NTHR, LDS_BYTES) != hipSuccess || per_cu < 1) fprintf(stderr, "kernel_launch: occupancy query says %d\n", per_cu);
        (void)hipGetLastError();
        grid = cus;
    }
    if (grid < 0) return;
    (void)hipMemsetAsync((char*)d_ws + WS_CTL, 0, CTL_ZERO_BYTES, stream);
    Args a{};
    a.x = (const float*)d_in[0]; a.ln_w = (const float*)d_in[1]; a.w_in = (const float*)d_in[2]; a.gn_w = (const float*)d_in[3];
    a.w_ro = (const float*)d_in[4]; a.w_mo = (const float*)d_in[5]; a.w_out = (const float*)d_in[6]; a.fn_w = (const float*)d_in[7];
    a.out = (float*)d_out; a.ws = (unsigned char*)d_ws; a.st_lo = 0; a.st_hi = NSTEPS;
    hipLaunchKernelGGL(hybrid_fwd, dim3(grid), dim3(NTHR), LDS_BYTES, stream, a);
}
```
